# Optimizing an MI355X kernel written in HIP

```python
import math
import jax, jax.numpy as jnp
from jax import lax
import numpy as np

D_MODEL = 1024
BATCH = 16
SEQ = 2048
DEPTH = 4

CTX_LEN = 256
GRID_W = 64
FN_GROUPS = 4
FN_GROUP_DIM = 128
FN_WIDTH = FN_GROUPS * FN_GROUP_DIM
DA_HEADS = 4
DA_HEAD_DIM = 64
DA_V_DIM = 2 * DA_HEAD_DIM
DA_QK_WIDTH = DA_HEADS * 2 * DA_HEAD_DIM
DA_V_WIDTH = DA_HEADS * DA_V_DIM
DA_Q_BLOCK = 128
NA_HEADS = 8
NA_HEAD_DIM = 64
NA_WIDTH = NA_HEADS * NA_HEAD_DIM
NA_ROWS = 8
NA_COLS = 16
NA_Q_BLOCK_W = 16
NA_K_BLOCK_W = 32
ROPE_THETA = 10000.0
ROPE_AXIS_DIM = DA_HEAD_DIM // 2
N_BRANCH = 3
PROJ_SPLITS = (
    FN_WIDTH,
    FN_WIDTH + DA_QK_WIDTH,
    FN_WIDTH + 2 * DA_QK_WIDTH,
    FN_WIDTH + 2 * DA_QK_WIDTH + DA_V_WIDTH,
    FN_WIDTH + 2 * DA_QK_WIDTH + DA_V_WIDTH + NA_WIDTH,
    FN_WIDTH + 2 * DA_QK_WIDTH + DA_V_WIDTH + 2 * NA_WIDTH,
    FN_WIDTH + 2 * DA_QK_WIDTH + DA_V_WIDTH + 3 * NA_WIDTH,
)
PROJ_WIDTH = PROJ_SPLITS[-1] + N_BRANCH * D_MODEL
D_FF = 2816
CONV_W = 3
N_MOD = 6
NORM_EPS = 1e-6
SUBLN_EPS = 1e-5
NEG_INF = -1e30

kernel_name = "hybrid_fnet_diffattn_natten_dit_block"


def rms_norm(x, g, eps=NORM_EPS):
    xf = x.astype(jnp.float32)
    y = xf * lax.rsqrt(jnp.mean(xf * xf, axis=-1, keepdims=True) + eps)
    return (y * g.astype(jnp.float32)).astype(x.dtype)


def modulate(h, shift, scale):
    return h * (1.0 + scale) + shift


def axial_rope_tables(n_tokens):
    t = jnp.arange(n_tokens, dtype=jnp.int32)
    row = (t // GRID_W).astype(jnp.float32)
    col = (t % GRID_W).astype(jnp.float32)
    n_freq = ROPE_AXIS_DIM // 2
    inv = ROPE_THETA ** (-jnp.arange(n_freq, dtype=jnp.float32) / n_freq)
    ang = jnp.stack([row[:, None] * inv, col[:, None] * inv], axis=1)
    return jnp.cos(ang), jnp.sin(ang)


def apply_axial_rope(x, cos, sin):
    shp = x.shape
    xr = x.astype(jnp.float32).reshape(shp[:-1] + (2, 2, ROPE_AXIS_DIM // 2))
    a, b = xr[..., 0, :], xr[..., 1, :]
    cb = cos[None, :, None, None]
    sb = sin[None, :, None, None]
    out = jnp.stack([a * cb - b * sb, a * sb + b * cb], axis=-2)
    return out.reshape(shp).astype(x.dtype)


def dwconv3(x, w, b):
    xp = jnp.pad(x, ((0, 0), (1, 1), (0, 0)))
    return xp[:, :-2] * w[0] + xp[:, 1:-1] * w[1] + xp[:, 2:] * w[2] + b


def fourier_mix(u):
    bsz, n, _ = u.shape
    ug = u.astype(jnp.float32).reshape(bsz, n, FN_GROUPS, FN_GROUP_DIM)
    f = jnp.fft.fft2(ug, axes=(1, 3), norm="ortho").real
    return f.reshape(bsz, n, FN_WIDTH).astype(u.dtype)


def diff_attend(q, k, v, lam):
    s = jnp.einsum('bqhmd,bkhmd->bhmqk', q, k).astype(jnp.float32) * (DA_HEAD_DIM ** -0.5)
    p = jax.nn.softmax(s, axis=-1)
    w = p[:, :, 0] - lam * p[:, :, 1]
    return jnp.einsum('bhqk,bkhe->bqhe', w.astype(v.dtype), v)


def diff_attention_latent(q, k_all, v_all, lam):
    bsz, n, h, m, d = q.shape
    nb = n // DA_Q_BLOCK
    qb = q.reshape(bsz, nb, DA_Q_BLOCK, h, m, d).swapaxes(0, 1)
    out = lax.map(lambda qi: diff_attend(qi, k_all, v_all, lam), qb)
    return out.swapaxes(0, 1).reshape(bsz, n, h, DA_V_DIM)


def softmax_attend(q, k, v):
    s = jnp.einsum('bqhd,bkhd->bhqk', q, k).astype(jnp.float32) * (q.shape[-1] ** -0.5)
    p = jax.nn.softmax(s, axis=-1).astype(v.dtype)
    return jnp.einsum('bhqk,bkhe->bqhe', p, v)


def neighbourhood_attention_latent(q, k, v, k_ctx, v_ctx, rpb):
    bsz, n, h, d = q.shape
    rows = n // GRID_W
    kh = min(NA_ROWS, rows)
    ncb = GRID_W // NA_Q_BLOCK_W
    qg = (q * (d ** -0.5)).reshape(bsz, rows, ncb, NA_Q_BLOCK_W, h, d)
    kg = k.reshape(bsz, rows, GRID_W, h, d)
    vg = v.reshape(bsz, rows, GRID_W, h, d)
    qcol = np.arange(GRID_W).reshape(ncb, NA_Q_BLOCK_W)
    c0 = np.clip(qcol - NA_COLS // 2, 0, GRID_W - NA_COLS)
    kc0 = np.clip(np.arange(ncb) * NA_Q_BLOCK_W - NA_COLS // 2, 0, GRID_W - NA_K_BLOCK_W)
    kcol = kc0[:, None] + np.arange(NA_K_BLOCK_W)
    col_ok = (kcol[:, None, :] >= c0[:, :, None]) & (kcol[:, None, :] < c0[:, :, None] + NA_COLS)
    dc = np.clip(kcol[:, None, :] - qcol[:, :, None] + NA_COLS - 1, 0, 2 * NA_COLS - 2)
    bias_c = rpb.astype(jnp.float32)[:, :, dc]
    bias_c = jnp.where(jnp.asarray(col_ok)[None, None], bias_c, NEG_INF)
    bias_c = jnp.transpose(bias_c, (0, 2, 3, 1, 4))
    kcol_j = jnp.asarray(kcol, dtype=jnp.int32)
    n_lat = kh * NA_K_BLOCK_W

    def one_row(r):
        r0 = jnp.clip(r - kh // 2, 0, rows - kh)
        q_r = lax.dynamic_index_in_dim(qg, r, axis=1, keepdims=False)
        k_rows = lax.dynamic_slice_in_dim(kg, r0, kh, axis=1)
        v_rows = lax.dynamic_slice_in_dim(vg, r0, kh, axis=1)
        k_blk = k_rows[:, :, kcol_j]
        v_blk = v_rows[:, :, kcol_j]
        bias = lax.dynamic_slice_in_dim(bias_c, r0 - r + NA_ROWS - 1, kh, axis=3)
        s_lat = jnp.einsum('bjqhd,bkjwhd->bhjqkw', q_r, k_blk).astype(jnp.float32) + bias
        s_ctx = jnp.einsum('bjqhd,bchd->bhjqc', q_r, k_ctx).astype(jnp.float32)
        s = jnp.concatenate([s_lat.reshape(s_lat.shape[:4] + (n_lat,)), s_ctx], axis=-1)
        p = jax.nn.softmax(s, axis=-1).astype(v.dtype)
        p_lat = p[..., :n_lat].reshape(s_lat.shape)
        p_ctx = p[..., n_lat:]
        o = (jnp.einsum('bhjqkw,bkjwhe->bjqhe', p_lat, v_blk)
             + jnp.einsum('bhjqc,bche->bjqhe', p_ctx, v_ctx))
        return o.reshape(bsz, GRID_W, h * d)

    out = lax.map(one_row, jnp.arange(rows, dtype=jnp.int32))
    return out.swapaxes(0, 1).reshape(bsz, n, h * d)


def mixer(h_lat, h_ctx, w_in, b_gate, w_a, lam_vec, subln_g, w_b, rpb, w_c, w_out,
          lam_init, cos, sin, with_ctx_out):
    bsz = h_lat.shape[0]
    w_fa, w_bq, w_bk, w_bv, w_cq, w_ck, w_cv, w_g = jnp.split(w_in, PROJ_SPLITS, axis=1)
    lv = lam_vec.astype(jnp.float32)
    lam = jnp.exp(jnp.sum(lv[0] * lv[1])) - jnp.exp(jnp.sum(lv[2] * lv[3])) + lam_init

    def da_qk(h, w):
        return (h @ w).reshape(h.shape[0], h.shape[1], DA_HEADS, 2, DA_HEAD_DIM)

    def heads(h, w, nh, dh):
        return (h @ w).reshape(h.shape[0], h.shape[1], nh, dh)

    def diff_post(o):
        return (rms_norm(o, subln_g, SUBLN_EPS) * (1.0 - lam_init)).reshape(bsz, o.shape[1], DA_V_WIDTH)

    def merge(h, fa, db, nc):
        gates = jax.nn.sigmoid(h @ w_g + b_gate)
        g_a, g_b, g_c = jnp.split(gates, N_BRANCH, axis=-1)
        return (g_a * (fa @ w_a) + g_b * (db @ w_b) + g_c * (nc @ w_c)) @ w_out

    kb_c = da_qk(h_ctx, w_bk)
    vb_c = heads(h_ctx, w_bv, DA_HEADS, DA_V_DIM)
    kc_c = heads(h_ctx, w_ck, NA_HEADS, NA_HEAD_DIM)
    vc_c = heads(h_ctx, w_cv, NA_HEADS, NA_HEAD_DIM)

    fa = fourier_mix(h_lat @ w_fa)
    qb = apply_axial_rope(da_qk(h_lat, w_bq), cos, sin)
    kb = apply_axial_rope(da_qk(h_lat, w_bk), cos, sin)
    vb = heads(h_lat, w_bv, DA_HEADS, DA_V_DIM)
    db = diff_post(diff_attention_latent(qb, jnp.concatenate([kb, kb_c], axis=1),
                                         jnp.concatenate([vb, vb_c], axis=1), lam))
    nc = neighbourhood_attention_latent(heads(h_lat, w_cq, NA_HEADS, NA_HEAD_DIM),
                                        heads(h_lat, w_ck, NA_HEADS, NA_HEAD_DIM),
                                        heads(h_lat, w_cv, NA_HEADS, NA_HEAD_DIM),
                                        kc_c, vc_c, rpb)
    y_lat = merge(h_lat, fa, db, nc)
    if not with_ctx_out:
        return y_lat, None

    n_ctx = h_ctx.shape[1]
    fa_c = fourier_mix(h_ctx @ w_fa)
    db_c = diff_post(diff_attend(da_qk(h_ctx, w_bq), kb_c, vb_c, lam))
    nc_c = softmax_attend(heads(h_ctx, w_cq, NA_HEADS, NA_HEAD_DIM), kc_c, vc_c).reshape(bsz, n_ctx, NA_WIDTH)
    y_ctx = merge(h_ctx, fa_c, db_c, nc_c)
    return y_lat, y_ctx


def conv_ffn(h, w_up, conv_w, conv_b, w_down):
    u = dwconv3(h @ w_up, conv_w, conv_b)
    a, b = jnp.split(u, 2, axis=-1)
    return (jax.nn.silu(a) * b) @ w_down


def setup_inputs(seed: int = 0) -> dict:
    key = jax.random.key(seed)
    ks = jax.random.split(key, 24)
    f32 = jnp.float32

    def nrm(k, shape, s):
        return s * jax.random.normal(k, shape, f32)

    L, D = DEPTH, D_MODEL
    return {
        "x": nrm(ks[0], (BATCH, SEQ, D), 1.0),
        "c": nrm(ks[1], (BATCH, D), 1.0),
        "ctx": nrm(ks[2], (BATCH, CTX_LEN, D), 1.0),
        "c_ctx": nrm(ks[3], (D,), 1.0),
        "w_ada": nrm(ks[4], (L, D, N_MOD * D), 0.5 * D ** -0.5),
        "b_ada": nrm(ks[5], (L, N_MOD * D), 0.02),
        "g_mix": 1.0 + nrm(ks[6], (L, D), 0.02),
        "g_ffn": 1.0 + nrm(ks[7], (L, D), 0.02),
        "w_in": nrm(ks[8], (L, D, PROJ_WIDTH), D ** -0.5),
        "b_gate": nrm(ks[9], (L, N_BRANCH * D), 0.02),
        "w_a": nrm(ks[10], (L, FN_WIDTH, D), FN_WIDTH ** -0.5),
        "lam": nrm(ks[11], (L, 4, DA_HEAD_DIM), 0.1),
        "subln_g": 1.0 + nrm(ks[12], (L, DA_V_DIM), 0.02),
        "w_b": nrm(ks[13], (L, DA_V_WIDTH, D), DA_V_WIDTH ** -0.5),
        "rpb": nrm(ks[14], (L, NA_HEADS, 2 * NA_ROWS - 1, 2 * NA_COLS - 1), 0.1),
        "w_c": nrm(ks[15], (L, NA_WIDTH, D), NA_WIDTH ** -0.5),
        "w_out": nrm(ks[16], (L, D, D), D ** -0.5),
        "w_up": nrm(ks[17], (L, D, 2 * D_FF), D ** -0.5),
        "conv_w": nrm(ks[18], (L, CONV_W, 2 * D_FF), CONV_W ** -0.5),
        "conv_b": nrm(ks[19], (L, 2 * D_FF), 0.02),
        "w_down": nrm(ks[20], (L, D_FF, D), D_FF ** -0.5),
        "g_final": 1.0 + nrm(ks[21], (D,), 0.02),
    }


def reference(x, c, ctx, c_ctx, w_ada, b_ada, g_mix, g_ffn, w_in, b_gate, w_a, lam,
              subln_g, w_b, rpb, w_c, w_out, w_up, conv_w, conv_b, w_down, g_final):
    n_tok = x.shape[1]
    cos, sin = axial_rope_tables(n_tok)
    silu_c = jax.nn.silu(c)
    silu_cc = jax.nn.silu(c_ctx)
    h_x = x
    h_c = ctx
    for l in range(DEPTH):
        last = l == DEPTH - 1
        lam_init = 0.8 - 0.6 * math.exp(-0.3 * l)
        mod = (silu_c @ w_ada[l] + b_ada[l])[:, None, :]
        mod_c = silu_cc @ w_ada[l] + b_ada[l]
        sh1, sc1, gt1, sh2, sc2, gt2 = jnp.split(mod, N_MOD, axis=-1)
        csh1, csc1, cgt1, csh2, csc2, cgt2 = jnp.split(mod_c, N_MOD, axis=-1)

        a_x = modulate(rms_norm(h_x, g_mix[l]), sh1, sc1)
        a_c = modulate(rms_norm(h_c, g_mix[l]), csh1, csc1)
        y_x, y_c = mixer(a_x, a_c, w_in[l], b_gate[l], w_a[l], lam[l], subln_g[l], w_b[l],
                         rpb[l], w_c[l], w_out[l], lam_init, cos, sin, not last)
        h_x = h_x + gt1 * y_x
        f_x = modulate(rms_norm(h_x, g_ffn[l]), sh2, sc2)
        h_x = h_x + gt2 * conv_ffn(f_x, w_up[l], conv_w[l], conv_b[l], w_down[l])
        if not last:
            h_c = h_c + cgt1 * y_c
            f_c = modulate(rms_norm(h_c, g_ffn[l]), csh2, csc2)
            h_c = h_c + cgt2 * conv_ffn(f_c, w_up[l], conv_w[l], conv_b[l], w_down[l])
    return rms_norm(h_x, g_final)
```

```cpp
#include <hip/hip_runtime.h>
#include <hip/hip_cooperative_groups.h>
#include <cstdio>
namespace cg = cooperative_groups;

#define LAS __attribute__((address_space(3)))
__device__ __forceinline__ int mytid_(int kwid) { int z = 0; asm volatile("" : "+v"(z)); return kwid * 64 + (int)__builtin_amdgcn_mbcnt_hi(~0u, __builtin_amdgcn_mbcnt_lo(~0u, (unsigned)z)); }
#define TIDX mytid_(kwid)
typedef unsigned short bf16_t;
typedef short bf16x8 __attribute__((ext_vector_type(8)));
typedef float f32x4 __attribute__((ext_vector_type(4)));
typedef unsigned u32x4 __attribute__((ext_vector_type(4)));
typedef unsigned u32x2 __attribute__((ext_vector_type(2)));

constexpr int D = 1024, NB = 16, SEQ = 2048, CTXL = 256, DEPTH = 4;
constexpr int MLAT = NB * SEQ, MCTX = NB * CTXL, MTOT = MLAT + MCTX;
constexpr int DFF = 2816, PROJW = 6656;
constexpr int NTHR = 512;
constexpr int LDS_BYTES = 147456;

constexpr size_t WS_WB = 0;
constexpr size_t WB_BYTES = 11534336;
constexpr size_t WS_DMAT = WS_WB + WB_BYTES;
constexpr size_t WS_DC = WS_DMAT + 16777216;
constexpr size_t WS_HC = WS_DC + 262144;
constexpr size_t WS_MOD = WS_HC + 16777216;
constexpr size_t WS_ROPE = WS_MOD + 1671168;
constexpr size_t WS_LAM = WS_ROPE + 8192;
constexpr size_t WS_ABUF = WS_LAM + 256;
constexpr size_t WS_BR = WS_ABUF + 75497472;
constexpr size_t WS_BIG = WS_BR + 113246208;
constexpr size_t BIG_PROJ = 0;
constexpr size_t BIG_T = 150994944;
constexpr size_t BIG_TC = BIG_T + 67108864;
constexpr size_t BIG_VTB = BIG_TC + 8388608;
constexpr size_t BIG_VTC = BIG_VTB + 37748736;
constexpr size_t BIG_BYTES = BIG_VTC + 37748736;
constexpr size_t BIG_MERGED = 0;
constexpr size_t BIG_GSCR = 75497472;
constexpr size_t BIG_SSCR = BIG_GSCR + 33554432;
constexpr size_t BIG_GATED = 0;
constexpr size_t BIG_HB = 207618048;
constexpr size_t BIG_WUP = 233570304;
constexpr size_t BIG_WDOWN = BIG_WUP + 11534336;
static_assert(BIG_WDOWN + 5767168 <= BIG_BYTES, "big");
constexpr size_t BIG_MODPART = 0;
constexpr size_t WS_BAR = WS_BIG + BIG_BYTES;
constexpr size_t WS_END = WS_BAR + 16384;
static_assert(WS_END <= 541745280ull, "workspace");

struct Params {
    const float *x, *c, *ctx, *c_ctx, *w_ada, *b_ada, *g_mix, *g_ffn, *w_in, *b_gate, *w_a, *lam, *subln_g, *w_b, *rpb, *w_c, *w_out, *w_up, *conv_w, *conv_b, *w_down, *g_final;
    float* out; unsigned char* ws;
};

__device__ __forceinline__ unsigned cvt_pk_bf16(float lo, float hi) { unsigned r; asm volatile("v_cvt_pk_bf16_f32 %0, %1, %2" : "=v"(r) : "v"(lo), "v"(hi)); return r; }
__device__ __forceinline__ int lv(int x) { asm volatile("" : "+v"(x)); return x; }
__device__ __forceinline__ int lsg(int x) { asm volatile("" : "+s"(x)); return x; }
__device__ __forceinline__ float bperm(float v, int srclane) { return __int_as_float(__builtin_amdgcn_ds_bpermute(srclane << 2, __float_as_int(v))); }
template <class T> __device__ __forceinline__ T* lptr(T* x) { asm volatile("" : "+s"(x)); return x; }
__device__ __forceinline__ float bf2f(unsigned short b) { return __uint_as_float(((unsigned)b) << 16); }
__device__ __forceinline__ u32x2 pack4(f32x4 v) { u32x2 w; w.x = cvt_pk_bf16(v[0], v[1]); w.y = cvt_pk_bf16(v[2], v[3]); return w; }
__device__ __forceinline__ f32x4 unpack4(u32x2 w) { f32x4 v; v[0] = __uint_as_float(w.x << 16); v[1] = __uint_as_float(w.x & 0xffff0000u); v[2] = __uint_as_float(w.y << 16); v[3] = __uint_as_float(w.y & 0xffff0000u); return v; }

constexpr int HTB = 128 * 64 * 2;
__device__ __forceinline__ int lds_byte(int r, int c) { const int st = (r >> 4) * 2 + (c >> 5), rr = r & 15, cc = c & 31, ob = rr * 64 + cc * 2; return st * 1024 + (ob ^ (((ob >> 9) & 1) << 5)); }
__device__ __forceinline__ void stage_rc(int b, int& R, int& C) { const int st = b / 1024, sb = b % 1024, swz = sb ^ (((sb >> 9) & 1) << 5); R = (st >> 1) * 16 + swz / 64; C = (st & 1) * 32 + (swz % 64) / 2; }

struct UnitD { const char* A; const char* B; int lda, ldb, nt; int pm, pn, kind, br; };

__device__ __forceinline__ bool tile_order(long L, int nM, int nN, int& pm, int& pn) {
    const int nwg = nM * nN; if (L >= nwg) return false;
    int wgid = (int)L; { const int q = nwg / 8, r = nwg % 8, xcd = wgid % 8, off = wgid / 8; wgid = (xcd < r ? xcd * (q + 1) : r * (q + 1) + (xcd - r) * q) + off; }
    const int nig = 8 * nN, gid = wgid / nig, fm = gid * 8, gsz = (nM - fm) < 8 ? (nM - fm) : 8;
    pm = fm + ((wgid % nig) % gsz); pn = (wgid % nig) / gsz; return true;
}

template <class P>
__device__ __forceinline__ void gemm_run(LAS unsigned char* lds, const P& pol, int kwid) {
    const int tid = lv(TIDX), wid = __builtin_amdgcn_readfirstlane(tid >> 6), lane = tid & 63, wr = wid >> 2, wc = wid & 3, fr = lane & 15, fq = lane >> 4;
    int R0_, C0_; { int R, C; stage_rc(tid * 16, R, C); R0_ = R; C0_ = C * 2; }
    const unsigned ldsw = (unsigned)wid * 1024u;
    const int aoff = lds_byte(wr * 64 + fr, fq * 8), boff = lds_byte(wc * 32 + fr, fq * 8);
#define G_SA(b, h) (((b) * 2 + (h)) * HTB)
#define G_SB(b, h) ((4 + (b) * 2 + (h)) * HTB)
#define G_STAGE(bufoff, gbase, ld) do { const unsigned _vo = (unsigned)(R0_ * (ld) + C0_); \
        __builtin_amdgcn_global_load_lds((const unsigned*)((const char*)(gbase) + _vo), (LAS unsigned*)(lds + (bufoff) + ldsw), 16, 0, 0); \
        __builtin_amdgcn_global_load_lds((const unsigned*)((const char*)(gbase) + 64 * (ld) + _vo), (LAS unsigned*)(lds + (bufoff) + ldsw + 8192), 16, 0, 0); } while (0)
#define G_LDA(dst, b, h) do { _Pragma("unroll") for (int m = 0; m < 4; ++m) _Pragma("unroll") for (int k = 0; k < 2; ++k) dst[m][k] = *(const LAS bf16x8*)(lds + G_SA(b, h) + aoff + m * 2048 + k * 1024); } while (0)
#define G_LDB(dst, b, h) do { _Pragma("unroll") for (int n = 0; n < 2; ++n) _Pragma("unroll") for (int k = 0; k < 2; ++k) dst[n][k] = *(const LAS bf16x8*)(lds + G_SB(b, h) + boff + n * 2048 + k * 1024); } while (0)
#define G_MMA(ai, bj, At, Bt) do { __builtin_amdgcn_s_setprio(1); _Pragma("unroll") for (int m = 0; m < 4; ++m) _Pragma("unroll") for (int n = 0; n < 2; ++n) _Pragma("unroll") for (int k = 0; k < 2; ++k) \
        acc[ai][bj][m][n] = __builtin_amdgcn_mfma_f32_16x16x32_bf16(Bt[n][k], At[m][k], acc[ai][bj][m][n], 0, 0, 0); __builtin_amdgcn_s_setprio(0); } while (0)
#define G_WAIT_V(n) asm volatile("s_waitcnt vmcnt(" #n ")" ::: "memory")
#define G_WAIT_L(n) asm volatile("s_waitcnt lgkmcnt(" #n ")" ::: "memory")
#define G_BAR __builtin_amdgcn_s_barrier()
#define G_SCHED __builtin_amdgcn_sched_barrier(0)
    UnitD cur, nxt; int ui = 0;
    if (!pol.unit(0, cur)) return;
    f32x4 acc[2][2][4][2];
#pragma unroll
    for (int a = 0; a < 2; ++a)
#pragma unroll
        for (int b = 0; b < 2; ++b)
#pragma unroll
            for (int m = 0; m < 4; ++m)
#pragma unroll
                for (int n = 0; n < 2; ++n) acc[a][b][m][n] = (f32x4){0.f, 0.f, 0.f, 0.f};
    bf16x8 At[4][2], B0[2][2], B1[2][2];
    const char* cA = cur.A; const char* cB = cur.B; int lda = cur.lda, ldb = cur.ldb;
    G_STAGE(G_SB(0, 0), cB, ldb); G_STAGE(G_SA(0, 0), cA, lda); G_STAGE(G_SB(0, 1), cB + 128 * ldb, ldb); G_STAGE(G_SA(0, 1), cA + 128 * lda, lda);
    if (wr == 1) G_BAR;
    G_WAIT_V(4); G_BAR;
    G_STAGE(G_SB(1, 0), cB + 128, ldb); G_STAGE(G_SA(1, 0), cA + 128, lda); G_STAGE(G_SB(1, 1), cB + 128 * ldb + 128, ldb);
    G_WAIT_V(6); G_BAR;
    for (;;) {
        const bool has_next = pol.unit(ui + 1, nxt);
        const char* nA = has_next ? nxt.A : cA; const char* nB = has_next ? nxt.B : cB;
        const int nlda = has_next ? nxt.lda : lda, nldb = has_next ? nxt.ldb : ldb;
        const int nt = cur.nt;
        for (int t = 0; t < nt; t += 2) {
            const bool last = (t == nt - 2);
            const char* a1 = cA + (size_t)(t + 1) * 128;
            const char* a2 = last ? nA : cA + (size_t)(t + 2) * 128; const char* b2 = last ? nB : cB + (size_t)(t + 2) * 128;
            const int la2 = last ? nlda : lda, lb2 = last ? nldb : ldb;
            const char* a3 = a2 + 128; const char* b3 = b2 + 128;
            G_LDB(B0, 0, 0); G_SCHED; G_LDA(At, 0, 0); G_STAGE(G_SA(1, 1), a1 + 128 * lda, lda);
            G_WAIT_L(8); G_BAR; G_WAIT_L(0); G_MMA(0, 0, At, B0); G_BAR; G_SCHED;
            G_LDB(B1, 0, 1); G_STAGE(G_SB(0, 0), b2, lb2);
            G_BAR; G_WAIT_L(0); G_MMA(0, 1, At, B1); G_BAR;
            G_LDA(At, 0, 1); G_STAGE(G_SA(0, 0), a2, la2);
            G_BAR; G_WAIT_L(0); G_MMA(1, 0, At, B0); G_BAR; G_SCHED;
            G_STAGE(G_SB(0, 1), b2 + 128 * lb2, lb2);
            G_WAIT_V(6); G_BAR; G_MMA(1, 1, At, B1); G_BAR;
            G_LDB(B0, 1, 0); G_SCHED; G_LDA(At, 1, 0); G_STAGE(G_SA(0, 1), a2 + 128 * la2, la2);
            G_WAIT_L(8); G_BAR; G_WAIT_L(0); G_MMA(0, 0, At, B0); G_BAR; G_SCHED;
            G_LDB(B1, 1, 1); G_STAGE(G_SB(1, 0), b3, lb2);
            G_BAR; G_WAIT_L(0); G_MMA(0, 1, At, B1); G_BAR;
            G_LDA(At, 1, 1); G_STAGE(G_SA(1, 0), a3, la2);
            G_BAR; G_WAIT_L(0); G_MMA(1, 0, At, B0); G_BAR; G_SCHED;
            G_STAGE(G_SB(1, 1), b3 + 128 * lb2, lb2);
            G_WAIT_V(6); G_BAR; G_MMA(1, 1, At, B1); G_BAR;
        }
        { const int t2 = lv(TIDX); pol.epi(acc, cur, wr, wc, t2 & 15, (t2 >> 4) & 3, t2); }
        if (!has_next) break;
#pragma unroll
        for (int a = 0; a < 2; ++a)
#pragma unroll
            for (int b = 0; b < 2; ++b)
#pragma unroll
                for (int m = 0; m < 4; ++m)
#pragma unroll
                    for (int n = 0; n < 2; ++n) acc[a][b][m][n] = (f32x4){0.f, 0.f, 0.f, 0.f};
        cur = nxt; cA = nA; cB = nB; lda = nlda; ldb = nldb; ++ui;
    }
    G_WAIT_V(0);
    if (wr == 0) G_BAR;
    G_BAR;
#undef G_SA
#undef G_SB
#undef G_STAGE
#undef G_LDA
#undef G_LDB
#undef G_MMA
}

__device__ __forceinline__ f32x4 sel4(bool c, f32x4 a, f32x4 b) { f32x4 r; r[0] = c ? a[0] : b[0]; r[1] = c ? a[1] : b[1]; r[2] = c ? a[2] : b[2]; r[3] = c ? a[3] : b[3]; return r; }
__device__ __forceinline__ f32x4 ldg4(const void* base, unsigned off) { return *(const f32x4*)((const char*)base + (size_t)off); }
__device__ __forceinline__ void stg2(void* base, unsigned off, u32x2 v) { *(u32x2*)((char*)base + (size_t)off) = v; }
typedef f32x4 Acc[2][2][4][2];

struct PolInProj {
    const char* abuf; const char* wt; bf16_t* proj; bf16_t* T; bf16_t* Tc; bf16_t* VtB; bf16_t* VtC; const LAS unsigned char* ropel; int G, c; int nostore;
    __device__ __forceinline__ bool unit(int i, UnitD& u) const {
        int pm, pn; if (!tile_order((long)i * G + c, 144, 16, pm, pn)) return false;
        u.pm = pm; u.pn = pn; u.lda = 2048; u.ldb = 2048; u.nt = 16; u.br = 0;
        const bool sw = (pn < 4) || (pn >= 12); u.kind = sw ? 1 : 0;
        const char* act = abuf + (size_t)pm * 256 * 2048; const char* w = wt + (size_t)pn * 256 * 2048;
        u.A = sw ? w : act; u.B = sw ? act : w; return true;
    }
    __device__ __forceinline__ void epi(Acc& acc, const UnitD& u, int wr, int wc, int fr, int fq, int tid) const {
        const int pm = u.pm, pn = u.pn;
        if (nostore) { float sink = 0.f; for (int a = 0; a < 2; ++a) for (int b = 0; b < 2; ++b) for (int m = 0; m < 4; ++m) for (int n = 0; n < 2; ++n) sink += acc[a][b][m][n][0] + acc[a][b][m][n][1] + acc[a][b][m][n][2] + acc[a][b][m][n][3]; if (sink == 123.456f) proj[0] = 0; return; }
        if (u.kind) {
            const bool lat = pm < 128; const int b = lat ? (pm >> 3) : (pm - 128);
            bf16_t* base; int rowlen;
            if (pn < 4) { const int part = pn >> 1, col0 = (pn & 1) * 256;
                if (lat) { base = T + ((size_t)(b * 512 + col0) * 4096 + part * 2048 + (pm & 7) * 256); rowlen = 4096; }
                else { base = Tc + ((size_t)(b * 512 + col0) * 512 + part * 256); rowlen = 512; } }
            else { bf16_t* vt = (pn < 14) ? VtB : VtC; const int col0 = (pn & 1) * 256;
                base = vt + ((size_t)(b * 512 + col0) * 2304 + (lat ? (pm & 7) * 256 : 2048)); rowlen = 2304; }
            if (pn < 14) {
#pragma unroll
                for (int ai = 0; ai < 2; ++ai)
#pragma unroll
                    for (int m = 0; m < 4; ++m) { const int r = ai * 128 + wr * 64 + m * 16 + fr; bf16_t* rp = base + (size_t)r * rowlen + wc * 32 + 8 * fq;
#pragma unroll
                        for (int bj = 0; bj < 2; ++bj) { const u32x2 p0 = pack4(acc[ai][bj][m][0]), p1 = pack4(acc[ai][bj][m][1]); u32x4 w; w.x = p0.x; w.y = p0.y; w.z = p1.x; w.w = p1.y; *(u32x4*)(rp + bj * 128) = w; } }
            } else {
#pragma unroll
                for (int ai = 0; ai < 2; ++ai)
#pragma unroll
                    for (int m = 0; m < 4; ++m) { const int r = ai * 128 + wr * 64 + m * 16 + fr; bf16_t* rp = base + (size_t)r * rowlen + wc * 32 + 4 * fq;
#pragma unroll
                        for (int bj = 0; bj < 2; ++bj)
#pragma unroll
                            for (int n = 0; n < 2; ++n) *(u32x2*)(rp + bj * 128 + n * 16) = pack4(acc[ai][bj][m][n]); }
            }
        } else {
            const bool dorope = (pn < 8) && (pm < 128); const float sc = (pn == 4 || pn == 5 || pn == 8 || pn == 9) ? 0.125f : 1.0f;
            const int colbase = (pn - 4) * 256 + wc * 32 + 8 * fq; const int axis = wc & 1;
#pragma unroll
            for (int ai = 0; ai < 2; ++ai)
#pragma unroll
                for (int m = 0; m < 4; ++m) { const int r = ai * 128 + wr * 64 + m * 16 + fr; const int tok = pm * 256 + r; const int t = tok & 2047;
                    const int pos = axis ? (t & 63) : (t >> 6);
                    f32x4 cs = (f32x4){1.f, 1.f, 1.f, 1.f}, sn = (f32x4){0.f, 0.f, 0.f, 0.f};
                    if (dorope) { cs = *(const LAS f32x4*)(ropel + (pos * 16 + 4 * fq) * 4); sn = *(const LAS f32x4*)(ropel + 4096 + (pos * 16 + 4 * fq) * 4); }
                    bf16_t* rp = proj + (size_t)tok * 2048 + colbase;
#pragma unroll
                    for (int bj = 0; bj < 2; ++bj) { const f32x4 a = acc[ai][bj][m][0], bb = acc[ai][bj][m][1];
                        const f32x4 o0 = (a * cs - bb * sn) * sc, o1 = (a * sn + bb * cs) * sc;
                        const u32x2 p0 = pack4(o0), p1 = pack4(o1); u32x4 w; w.x = p0.x; w.y = p0.y; w.z = p1.x; w.w = p1.y; *(u32x4*)(rp + bj * 128) = w; } }
        }
    }
};

struct PolDft {
    const char* dmat; const char* dc; const char* T; const char* Tc; bf16_t* br; int G, c, nU;
    __device__ __forceinline__ bool unit(int i, UnitD& u) const {
        const long L = (long)i * G + c; if (L >= nU) return false;
        if (L < 256) { const int b = (int)L >> 4, pm = ((int)L >> 1) & 7, pn = (int)L & 1;
            u.A = dmat + (size_t)pm * 256 * 8192; u.lda = 8192; u.B = T + ((size_t)(b * 512 + pn * 256) * 4096) * 2; u.ldb = 8192; u.nt = 64; u.pm = b * 8 + pm; u.pn = pn; u.kind = 0; }
        else { const int b = ((int)L - 256) >> 1, pn = (int)L & 1;
            u.A = dc; u.lda = 1024; u.B = Tc + ((size_t)(b * 512 + pn * 256) * 512) * 2; u.ldb = 1024; u.nt = 8; u.pm = 128 + b; u.pn = pn; u.kind = 1; }
        u.br = 0; return true;
    }
    __device__ __forceinline__ void epi(Acc& acc, const UnitD& u, int wr, int wc, int fr, int fq, int tid) const {
        const float sc = u.kind ? 0.0055242717280199f : 0.001953125f;
#pragma unroll
        for (int ai = 0; ai < 2; ++ai)
#pragma unroll
            for (int m = 0; m < 4; ++m) { const int r = ai * 128 + wr * 64 + m * 16 + fr; bf16_t* rp = br + (size_t)(u.pm * 256 + r) * 1536 + u.pn * 256 + wc * 32 + 4 * fq;
#pragma unroll
                for (int bj = 0; bj < 2; ++bj)
#pragma unroll
                    for (int n = 0; n < 2; ++n) *(u32x2*)(rp + bj * 128 + n * 16) = pack4(acc[ai][bj][m][n] * sc); }
    }
};

struct PolMerge {
    const char* abuf; const char* brb; const char* wm; const float* bgate; u32x4* gscr; f32x4* sscr; bf16_t* merged; int G, c, nM;
    __device__ __forceinline__ bool unit(int i, UnitD& u) const {
        const int ti = i / 6, s = i - ti * 6; int pm, pn; if (!tile_order((long)ti * G + c, nM, 4, pm, pn)) return false;
        const int br = s >> 1; u.pm = pm; u.pn = pn; u.br = br; u.kind = s & 1; u.ldb = 3072;
        if (!(s & 1)) { u.A = abuf + (size_t)pm * 256 * 2048; u.lda = 2048; u.B = wm + ((size_t)(br * 1024 + pn * 256) * 1536) * 2; u.nt = 16; }
        else { u.A = brb + ((size_t)pm * 256 * 1536 + br * 512) * 2; u.lda = 3072; u.B = wm + ((size_t)(br * 1024 + pn * 256) * 1536 + 1024) * 2; u.nt = 8; }
        return true;
    }
    __device__ __forceinline__ void epi(Acc& acc, const UnitD& u, int wr, int wc, int fr, int fq, int tid) const {
        u32x4* gs = gscr + (size_t)blockIdx.x * 16 * 512 + tid; u32x4* ss = (u32x4*)sscr + (size_t)blockIdx.x * 16 * 512 + tid;
        if (u.kind == 0) {
            const float* bp = bgate + u.br * 1024 + u.pn * 256 + wc * 32 + 4 * fq;
#pragma unroll
            for (int bj = 0; bj < 2; ++bj) { const f32x4 b0 = *(const f32x4*)(bp + bj * 128), b1 = *(const f32x4*)(bp + bj * 128 + 16);
#pragma unroll
                for (int ai = 0; ai < 2; ++ai)
#pragma unroll
                    for (int m = 0; m < 4; ++m) { f32x4 v0 = acc[ai][bj][m][0] + b0, v1 = acc[ai][bj][m][1] + b1;
#pragma unroll
                        for (int j = 0; j < 4; ++j) { v0[j] = __builtin_amdgcn_rcpf(1.0f + __expf(-v0[j])); v1[j] = __builtin_amdgcn_rcpf(1.0f + __expf(-v1[j])); }
                        const u32x2 p0 = pack4(v0), p1 = pack4(v1); u32x4 w; w.x = p0.x; w.y = p0.y; w.z = p1.x; w.w = p1.y;
                        gs[((ai * 2 + bj) * 4 + m) * 512] = w; asm volatile("" ::: "memory"); } }
        } else {
            u32x4* sb = (u32x4*)ss;
            const f32x4 z4 = (f32x4){0.f, 0.f, 0.f, 0.f}; const bool addS = u.br > 0;
#pragma unroll
            for (int ai = 0; ai < 2; ++ai) {
                u32x4 gw[4][2], sw[4][2];
#pragma unroll
                for (int m = 0; m < 4; ++m)
#pragma unroll
                    for (int bj = 0; bj < 2; ++bj) { const int gi = ((ai * 2 + bj) * 4 + m); gw[m][bj] = gs[gi * 512]; sw[m][bj] = sb[gi * 512]; }
                asm volatile("" ::: "memory");
#pragma unroll
                for (int m = 0; m < 4; ++m) { const int r = ai * 128 + wr * 64 + m * 16 + fr; bf16_t* rp = merged + (size_t)(u.pm * 256 + r) * 1024 + u.pn * 256 + wc * 32 + 4 * fq;
#pragma unroll
                    for (int bj = 0; bj < 2; ++bj) { const int gi = ((ai * 2 + bj) * 4 + m); const u32x4 w = gw[m][bj], q = sw[m][bj];
                        u32x2 p0; p0.x = w.x; p0.y = w.y; u32x2 p1; p1.x = w.z; p1.y = w.w; u32x2 q0; q0.x = q.x; q0.y = q.y; u32x2 q1; q1.x = q.z; q1.y = q.w;
                        const f32x4 v0 = unpack4(p0) * acc[ai][bj][m][0] + sel4(addS, unpack4(q0), z4), v1 = unpack4(p1) * acc[ai][bj][m][1] + sel4(addS, unpack4(q1), z4);
                        const u32x2 o0 = pack4(v0), o1 = pack4(v1);
                        if (u.br < 2) { u32x4 o; o.x = o0.x; o.y = o0.y; o.z = o1.x; o.w = o1.y; sb[gi * 512] = o; }
                        else { *(u32x2*)(rp + bj * 128) = o0; *(u32x2*)(rp + bj * 128 + 16) = o1; } } }
                asm volatile("" ::: "memory");
            }
        }
    }
};

struct PolResid {
    const char* A; int lda; const char* wt; int ldb; int nt; const float* hx_in; float* hx_out; const float* hc_in; float* hc_out; const float* modl; int gidx; int G, c, nM;
    __device__ __forceinline__ bool unit(int i, UnitD& u) const {
        int pm, pn; if (!tile_order((long)i * G + c, nM, 4, pm, pn)) return false;
        u.pm = pm; u.pn = pn; u.kind = 0; u.br = 0; u.lda = lda; u.ldb = ldb; u.nt = nt;
        u.A = A + (size_t)pm * 256 * lda; u.B = wt + (size_t)pn * 256 * ldb; return true;
    }
    __device__ __forceinline__ void epi(Acc& acc, const UnitD& u, int wr, int wc, int fr, int fq, int tid) const {
        const bool lat = u.pm < 128; const int brow = lat ? (u.pm >> 3) : 16;
        const float* hin = lat ? hx_in + (size_t)u.pm * 256 * 1024 : hc_in + (size_t)(u.pm - 128) * 256 * 1024;
        float* hout = lat ? hx_out + (size_t)u.pm * 256 * 1024 : hc_out + (size_t)(u.pm - 128) * 256 * 1024;
        const int col0 = u.pn * 256 + wc * 32 + 4 * fq;
        const float* gp = modl + (size_t)brow * 6144 + gidx * 1024 + col0;
#pragma unroll
        for (int bj = 0; bj < 2; ++bj)
#pragma unroll
            for (int n = 0; n < 2; ++n) { const f32x4 g = *(const f32x4*)(gp + bj * 128 + n * 16);
#pragma unroll
                for (int ai = 0; ai < 2; ++ai)
#pragma unroll
                    for (int m = 0; m < 4; ++m) { const int r = ai * 128 + wr * 64 + m * 16 + fr; const unsigned off = (unsigned)(r * 1024 + col0 + bj * 128 + n * 16) * 4u;
                        acc[ai][bj][m][n] = ldg4(hin, off) + g * acc[ai][bj][m][n]; } }
        asm volatile("" ::: "memory");
#pragma unroll
        for (int ai = 0; ai < 2; ++ai)
#pragma unroll
            for (int m = 0; m < 4; ++m)
#pragma unroll
                for (int bj = 0; bj < 2; ++bj)
#pragma unroll
                    for (int n = 0; n < 2; ++n) { const int r = ai * 128 + wr * 64 + m * 16 + fr; const unsigned off = (unsigned)(r * 1024 + col0 + bj * 128 + n * 16) * 4u;
                        *(f32x4*)((char*)hout + (size_t)off) = acc[ai][bj][m][n]; }
    }
};

__device__ __forceinline__ f32x4 rot4(f32x4 v, int src) { f32x4 r; r[0] = bperm(v[0], src); r[1] = bperm(v[1], src); r[2] = bperm(v[2], src); r[3] = bperm(v[3], src); return r; }
struct PolUp {
    const char* abuf; const char* wt; const float* cw; const float* cb; bf16_t* gated; bf16_t* hb; int G, c, nM; LAS unsigned char* ldsx;
    __device__ __forceinline__ bool unit(int i, UnitD& u) const {
        int pm, pn; if (!tile_order((long)i * G + c, nM, 22, pm, pn)) return false;
        u.pm = pm; u.pn = pn; u.kind = 0; u.br = 0; u.lda = 2048; u.ldb = 2048; u.nt = 16;
        u.A = abuf + (size_t)pm * 256 * 2048; u.B = wt + (size_t)pn * 256 * 2048; return true;
    }
    __device__ __forceinline__ void epi(Acc& acc, const UnitD& u, int wr, int wc, int fr, int fq, int tid) const {
        const int lane = tid & 63; const int srcR = (lane & 48) | ((fr + 15) & 15), srcL = (lane & 48) | ((fr + 1) & 15);
        LAS unsigned char* wl = ldsx + (wr * 4 + wc) * 1024;
        { const int arr = lane & 3, fqv = (lane >> 2) & 3, hfv = (lane >> 4) & 1, nv = (lane >> 5) & 1;
          const int cidx = hfv * DFF + u.pn * 128 + wc * 32 + nv * 16 + 4 * fqv;
          const f32x4 v = (arr < 3) ? ldg4(cw, (unsigned)(arr * 2 * DFF + cidx) * 4u) : ldg4(cb, (unsigned)cidx * 4u);
          *(LAS f32x4*)(wl + lane * 16) = v; asm volatile("s_waitcnt lgkmcnt(0)" ::: "memory"); }
#pragma unroll
        for (int n = 0; n < 2; ++n) {
            const int ja = u.pn * 128 + wc * 32 + n * 16 + 4 * fq;
#pragma unroll
            for (int ai = 0; ai < 2; ++ai) {
                const int seg = u.pm * 4 + ai * 2 + wr;
                asm volatile("" : "+v"(acc[ai][0][0][n]), "+v"(acc[ai][0][1][n]), "+v"(acc[ai][0][2][n]), "+v"(acc[ai][0][3][n]), "+v"(acc[ai][1][0][n]), "+v"(acc[ai][1][1][n]), "+v"(acc[ai][1][2][n]), "+v"(acc[ai][1][3][n]) :: "memory");
                f32x4 uv[2][4];
#pragma unroll
                for (int hf = 1; hf >= 0; --hf) {
                    const LAS f32x4* wv = (const LAS f32x4*)(wl + ((n * 2 + hf) * 4 + fq) * 64);
                    const f32x4 w0 = wv[0], w1 = wv[1], w2 = wv[2], bb = wv[3];
                    f32x4 rrp = rot4(acc[ai][hf][0][n], srcR), rlc = rot4(acc[ai][hf][0][n], srcL);
#pragma unroll
                    for (int m = 0; m < 4; ++m) {
                        const f32x4 rrc = (m == 0) ? rrp : rot4(acc[ai][hf][m][n], srcR);
                        const f32x4 rln = (m < 3) ? rot4(acc[ai][hf][m + 1][n], srcL) : rlc;
                        const f32x4 prev = sel4(fr > 0, rrc, rrp);
                        const f32x4 next = sel4(fr < 15, rlc, rln);
                        uv[hf][m] = w0 * prev + w1 * acc[ai][hf][m][n] + w2 * next + bb;
                        rrp = rrc; rlc = rln;
                    }
                    __builtin_amdgcn_sched_barrier(0);
                }
#pragma unroll
                for (int m = 0; m < 4; ++m) {
                    const int r = ai * 128 + wr * 64 + m * 16 + fr;
                    const bool bnd = (m == 0 && fr == 0) || (m == 3 && fr == 15);
                    if (!bnd) { f32x4 g;
#pragma unroll
                        for (int j = 0; j < 4; ++j) { const float a = uv[0][m][j]; g[j] = a * __builtin_amdgcn_rcpf(1.0f + __expf(-a)) * uv[1][m][j]; }
                        stg2(gated, ((unsigned)(u.pm * 256 + r) * (unsigned)DFF + (unsigned)ja) * 2u, pack4(g)); }
                    if (m == 0 && fr < 2) {
#pragma unroll
                        for (int hf = 0; hf < 2; ++hf) stg2(hb, ((unsigned)(seg * 4 + fr) * (unsigned)(2 * DFF) + (unsigned)(hf * DFF + ja)) * 2u, pack4(acc[ai][hf][m][n])); }
                    if (m == 3 && fr >= 14) {
#pragma unroll
                        for (int hf = 0; hf < 2; ++hf) stg2(hb, ((unsigned)(seg * 4 + fr - 12) * (unsigned)(2 * DFF) + (unsigned)(hf * DFF + ja)) * 2u, pack4(acc[ai][hf][m][n])); }
                }
                asm volatile("" ::: "memory"); __builtin_amdgcn_sched_barrier(0);
            }
        }
    }
};

#define SHX(v, mask) bperm((v), lane ^ (mask))
__device__ __forceinline__ float wave_sum(float v, int lane) { v += SHX(v, 32); v += SHX(v, 16); v += SHX(v, 8); v += SHX(v, 4); v += SHX(v, 2); v += SHX(v, 1); return v; }

__device__ __forceinline__ void conv_win_fold(const Params& p, unsigned char* ws, int l, float* tl, int wgi, int nwg, int kwid) {
    const float* src = p.w_in + (size_t)l * D * PROJW; bf16_t* dst = (bf16_t*)(ws + WS_WB);
    float* wsm = tl; float* tw = tl + 64 * 129;
    const int tid = lv(TIDX);
    if (wgi < 0) return;
    for (int it = wgi; it < 256; it += nwg) { const int g = it >> 6, k0 = ((it >> 2) & 15) * 64, cqb = (it & 3) * 32;
        if (tid < 128) { float s, c; sincospif((float)tid / 64.0f, &s, &c); tw[tid] = c; tw[128 + tid] = s; }
        for (int e = tid; e < 64 * 128; e += NTHR) { const int kk = e >> 7, cc = e & 127; wsm[kk * 129 + cc] = src[(size_t)(k0 + kk) * PROJW + g * 128 + cc]; }
        __syncthreads();
        const int kk = tid & 63, cq0 = tid >> 6;
        for (int i = 0; i < 4; ++i) { const int cp = cqb + cq0 + 8 * i; float ac = 0.f, as = 0.f;
            for (int cc = 0; cc < 128; ++cc) { const float w = wsm[kk * 129 + cc]; const int ix = (cc * cp) & 127; ac += w * tw[ix]; as += w * tw[128 + ix]; }
            dst[(size_t)(g * 128 + cp) * 1024 + k0 + kk] = (bf16_t)(cvt_pk_bf16(ac, 0.f) & 0xffff);
            dst[(size_t)(512 + g * 128 + cp) * 1024 + k0 + kk] = (bf16_t)(cvt_pk_bf16(as, 0.f) & 0xffff); }
        __syncthreads(); }
}
struct ConvD { const float* src; int sld, k0, scol0; bf16_t* dst; int dld, drow0, dk0; };
__device__ __forceinline__ ConvD conv_desc(const Params& p, unsigned char* ws, int l, int kind, int it) {
    ConvD d; bf16_t* wb = (bf16_t*)(ws + WS_WB);
    if (kind == 0) { const int rt = it >> 4, kt = it & 15; const int blk = rt >> 3, within = (rt & 7) * 64;
        const int sc0 = (blk == 0 ? 512 : blk == 1 ? 1024 : blk == 2 ? 2048 : blk == 3 ? 2560 : blk == 4 ? 1536 : 3072) + within;
        d.src = p.w_in + (size_t)l * D * PROJW; d.sld = PROJW; d.k0 = kt * 64; d.scol0 = sc0; d.dst = wb; d.dld = 1024; d.drow0 = 1024 + rt * 64; d.dk0 = kt * 64; }
    else if (kind == 1) {
        if (it < 1152) { const int rt = it / 24, kt = it % 24; const int br = rt >> 4, n0 = (rt & 15) * 64; d.dst = wb; d.dld = 1536; d.drow0 = br * 1024 + n0;
            if (kt < 16) { d.src = p.w_in + (size_t)l * D * PROJW; d.sld = PROJW; d.k0 = kt * 64; d.scol0 = 3584 + br * 1024 + n0; d.dk0 = kt * 64; }
            else { d.src = (br == 0 ? p.w_a : br == 1 ? p.w_b : p.w_c) + (size_t)l * 512 * 1024; d.sld = 1024; d.k0 = (kt - 16) * 64; d.scol0 = n0; d.dk0 = 1024 + (kt - 16) * 64; } }
        else { const int j = it - 1152; const int rt = j >> 4, kt = j & 15; d.src = p.w_out + (size_t)l * 1024 * 1024; d.sld = 1024; d.k0 = kt * 64; d.scol0 = rt * 64; d.dst = (bf16_t*)(ws + WS_WB + 9437184); d.dld = 1024; d.drow0 = rt * 64; d.dk0 = kt * 64; } }
    else if (kind == 2) { const int rt = it >> 4, kt = it & 15; const int drow0 = rt * 64; const int pn = drow0 >> 8, bj = (drow0 >> 7) & 1, i0 = drow0 & 127;
        d.src = p.w_up + (size_t)l * 1024 * 5632; d.sld = 5632; d.k0 = kt * 64; d.scol0 = bj * DFF + pn * 128 + i0; d.dst = (bf16_t*)(ws + WS_BIG + BIG_WUP); d.dld = 1024; d.drow0 = drow0; d.dk0 = kt * 64; }
    else { const int rt = it / 44, kt = it % 44; d.src = p.w_down + (size_t)l * DFF * 1024; d.sld = 1024; d.k0 = kt * 64; d.scol0 = rt * 64; d.dst = (bf16_t*)(ws + WS_BIG + BIG_WDOWN); d.dld = DFF; d.drow0 = rt * 64; d.dk0 = kt * 64; }
    return d;
}
__device__ __forceinline__ void conv_run(const Params& p, unsigned char* ws, int l, int kind, int ntiles, float* tl, int wgi, int nwg, int kwid) {
    const int tid = lv(TIDX);
    if (wgi < 0) return;
    for (int base = wgi * 4; base < ntiles; base += nwg * 4) {
#pragma unroll
        for (int q = 0; q < 4; ++q) { if (base + q < ntiles) { const ConvD d = conv_desc(p, ws, l, kind, base + q); float* t = tl + q * (64 * 65);
#pragma unroll
            for (int i = 0; i < 2; ++i) { const int kk = (tid >> 4) + 32 * i, c4 = (tid & 15) * 4;
                const f32x4 v = *(const f32x4*)(d.src + (size_t)(d.k0 + kk) * d.sld + d.scol0 + c4);
                t[kk * 65 + c4] = v[0]; t[kk * 65 + c4 + 1] = v[1]; t[kk * 65 + c4 + 2] = v[2]; t[kk * 65 + c4 + 3] = v[3]; } } }
        __syncthreads();
#pragma unroll
        for (int q = 0; q < 4; ++q) { if (base + q < ntiles) { const ConvD d = conv_desc(p, ws, l, kind, base + q); const float* t = tl + q * (64 * 65);
            const int r = tid >> 3, k8 = (tid & 7) * 8; float f[8];
#pragma unroll
            for (int j = 0; j < 8; ++j) f[j] = t[(k8 + j) * 65 + r];
            u32x4 w; w.x = cvt_pk_bf16(f[0], f[1]); w.y = cvt_pk_bf16(f[2], f[3]); w.z = cvt_pk_bf16(f[4], f[5]); w.w = cvt_pk_bf16(f[6], f[7]);
            *(u32x4*)(d.dst + (size_t)(d.drow0 + r) * d.dld + d.dk0 + k8) = w; } }
        __syncthreads();
    }
}
__device__ __forceinline__ void norm_phase(const float* hx, const float* hc, const float* g, const float* modl, int ish, int isc, bf16_t* abuf, int G, int nrows, int kwid) {
    const int tid_ = lv(TIDX); const int wave = tid_ >> 6, lane = tid_ & 63;
    for (int rowb = blockIdx.x * 8 + wave; rowb < nrows; rowb += G * 32) {
        f32x4 v[4][4]; int rows[4];
#pragma unroll
        for (int q = 0; q < 4; ++q) { const int r = rowb + q * G * 8; rows[q] = r; const int rc = r < nrows ? r : rowb;
            const float* src = (rc < MLAT) ? hx + (size_t)rc * 1024 : hc + (size_t)(rc - MLAT) * 1024;
#pragma unroll
            for (int i = 0; i < 4; ++i) v[q][i] = *(const f32x4*)(src + lane * 4 + 256 * i); }
#pragma unroll
        for (int q = 0; q < 4; ++q) { const int row = rows[q]; if (row < nrows) {
            const int brow = (row < MLAT) ? (row >> 11) : 16; const float* mp = modl + (size_t)brow * 6144;
            float ss = 0.f;
#pragma unroll
            for (int i = 0; i < 4; ++i) ss += v[q][i][0] * v[q][i][0] + v[q][i][1] * v[q][i][1] + v[q][i][2] * v[q][i][2] + v[q][i][3] * v[q][i][3];
            ss = wave_sum(ss, lane); const float rstd = rsqrtf(ss * (1.0f / 1024.0f) + 1e-6f);
#pragma unroll
            for (int i = 0; i < 4; ++i) { const int k = lane * 4 + 256 * i; const f32x4 gg = *(const f32x4*)(g + k), sh = *(const f32x4*)(mp + ish * 1024 + k), sc = *(const f32x4*)(mp + isc * 1024 + k);
                const f32x4 o = (v[q][i] * rstd * gg) * (sc + 1.0f) + sh; *(u32x2*)(abuf + (size_t)row * 1024 + k) = pack4(o); } } }
    }
}
__device__ __forceinline__ void final_norm(float* out, const float* g, int G, int kwid) {
    const int tid_ = lv(TIDX); const int wave = tid_ >> 6, lane = tid_ & 63;
    for (int rowb = blockIdx.x * 8 + wave; rowb < MLAT; rowb += G * 32) {
        f32x4 v[4][4];
#pragma unroll
        for (int q = 0; q < 4; ++q) { const int r = rowb + q * G * 8; const int rc = r < MLAT ? r : rowb;
#pragma unroll
            for (int i = 0; i < 4; ++i) v[q][i] = *(const f32x4*)(out + (size_t)rc * 1024 + lane * 4 + 256 * i); }
#pragma unroll
        for (int q = 0; q < 4; ++q) { const int row = rowb + q * G * 8; if (row < MLAT) { float ss = 0.f;
#pragma unroll
            for (int i = 0; i < 4; ++i) ss += v[q][i][0] * v[q][i][0] + v[q][i][1] * v[q][i][1] + v[q][i][2] * v[q][i][2] + v[q][i][3] * v[q][i][3];
            ss = wave_sum(ss, lane); const float rstd = rsqrtf(ss * (1.0f / 1024.0f) + 1e-6f);
#pragma unroll
            for (int i = 0; i < 4; ++i) { const int k = lane * 4 + 256 * i; const f32x4 gg = *(const f32x4*)(g + k); *(f32x4*)(out + (size_t)row * 1024 + k) = v[q][i] * rstd * gg; } } }
    }
}

__device__ __forceinline__ void fixup_phase(const bf16_t* hb, const float* cw, const float* cb, bf16_t* gated, int G, int nseg_all, int kwid) {
    const int total = nseg_all * 2 * (DFF / 4);
    for (int e = blockIdx.x * NTHR + lv(TIDX); e < total; e += G * NTHR) {
        const int j4 = (e % (DFF / 4)) * 4; const int sr = e / (DFF / 4); const int seg = sr >> 1, which = sr & 1;
        const bool lat = seg < 512; const int sl = lat ? (seg & 31) : ((seg - 512) & 3); const int nseg = lat ? 32 : 4;
        const bf16_t* pprev; const bf16_t* pcur; const bf16_t* pnext; bool zp = false, zn = false; int row;
        if (which == 0) { row = seg * 64; pcur = hb + (size_t)(seg * 4 + 0) * (2 * DFF); pnext = hb + (size_t)(seg * 4 + 1) * (2 * DFF); zp = (sl == 0); pprev = zp ? pcur : hb + (size_t)((seg - 1) * 4 + 3) * (2 * DFF); }
        else { row = seg * 64 + 63; pcur = hb + (size_t)(seg * 4 + 3) * (2 * DFF); pprev = hb + (size_t)(seg * 4 + 2) * (2 * DFF); zn = (sl == nseg - 1); pnext = zn ? pcur : hb + (size_t)((seg + 1) * 4 + 0) * (2 * DFF); }
        f32x4 uu[2];
#pragma unroll
        for (int hf = 0; hf < 2; ++hf) { const int cidx = hf * DFF + j4;
            f32x4 pv = unpack4(*(const u32x2*)(pprev + cidx)), cv = unpack4(*(const u32x2*)(pcur + cidx)), nv = unpack4(*(const u32x2*)(pnext + cidx));
            if (zp) pv = (f32x4){0.f, 0.f, 0.f, 0.f}; if (zn) nv = (f32x4){0.f, 0.f, 0.f, 0.f};
            uu[hf] = *(const f32x4*)(cw + cidx) * pv + *(const f32x4*)(cw + 2 * DFF + cidx) * cv + *(const f32x4*)(cw + 4 * DFF + cidx) * nv + *(const f32x4*)(cb + cidx); }
        f32x4 gg;
#pragma unroll
        for (int j = 0; j < 4; ++j) { const float a = uu[0][j]; gg[j] = a * __builtin_amdgcn_rcpf(1.0f + __expf(-a)) * uu[1][j]; }
        *(u32x2*)(gated + (size_t)row * DFF + j4) = pack4(gg);
    }
}

__device__ __forceinline__ void prep_a(const Params& p, unsigned char* ws, float* tl, int G, int kwid) {
    const int tid = lv(TIDX);
    float* modpart = (float*)(ws + WS_BIG + BIG_MODPART);
    for (int it = blockIdx.x; it < 4 * 24 * 8; it += G) { const int kc = it & 7, nc = (it >> 3) % 24, l = it / 192;
        __syncthreads();
        for (int e = tid; e < 17 * 128; e += NTHR) { const int r = e >> 7, k = e & 127; const float v = (r < 16) ? p.c[r * 1024 + kc * 128 + k] : p.c_ctx[kc * 128 + k]; tl[e] = v / (1.0f + __expf(-v)); }
        __syncthreads();
        const int col = nc * 256 + (tid & 255), kh = tid >> 8; float acc[17];
#pragma unroll
        for (int r = 0; r < 17; ++r) acc[r] = 0.f;
        const float* wp = p.w_ada + (size_t)l * 1024 * 6144 + (size_t)(kc * 128 + kh * 64) * 6144 + col;
        for (int k = 0; k < 64; ++k) { const float w = wp[(size_t)k * 6144];
#pragma unroll
            for (int r = 0; r < 17; ++r) acc[r] += tl[r * 128 + kh * 64 + k] * w; }
        float* xs = tl + 17 * 128;
        if (kh == 1) {
#pragma unroll
            for (int r = 0; r < 17; ++r) xs[r * 256 + (tid & 255)] = acc[r]; }
        __syncthreads();
        if (kh == 0) {
#pragma unroll
            for (int r = 0; r < 17; ++r) modpart[((size_t)(kc * 4 + l) * 17 + r) * 6144 + col] = acc[r] + xs[r * 256 + (tid & 255)]; }
    }
    { float* rope = (float*)(ws + WS_ROPE);
      for (int e = blockIdx.x * NTHR + tid; e < 1024; e += G * NTHR) { const int pos = e >> 4, f = e & 15; const float inv = powf(10000.0f, -(float)f / 16.0f); const float ang = (float)pos * inv; rope[e] = cosf(ang); rope[1024 + e] = sinf(ang); } }
    if (blockIdx.x == 0 && tid < 64) { float* lamv = (float*)(ws + WS_LAM);
        for (int l = 0; l < 4; ++l) { const float* lv = p.lam + l * 256; const int lane = tid & 63; const float s1 = wave_sum(lv[tid] * lv[64 + tid], lane), s2 = wave_sum(lv[128 + tid] * lv[192 + tid], lane);
            if (tid == 0) lamv[l] = expf(s1) - expf(s2) + (0.8f - 0.6f * expf(-0.3f * (float)l)); } }
    __syncthreads();
    for (int e = tid; e < 2048; e += NTHR) tl[e] = cospif((float)e / 1024.0f);
    __syncthreads();
    { bf16_t* dm = (bf16_t*)(ws + WS_DMAT);
      for (int e = blockIdx.x * NTHR + tid; e < 2048 * 512; e += G * NTHR) { const int n = e >> 9, k8 = (e & 511) * 8; float f[8];
#pragma unroll
          for (int j = 0; j < 8; ++j) { const int kp = k8 + j; const int k = (kp & ~31) | (((kp >> 2) & 1) << 4) | (((kp >> 3) & 3) << 2) | (kp & 3); f[j] = (k < 2048) ? tl[(n * k) & 2047] : -tl[(n * (k - 2048) + 1536) & 2047]; }
          u32x4 w; w.x = cvt_pk_bf16(f[0], f[1]); w.y = cvt_pk_bf16(f[2], f[3]); w.z = cvt_pk_bf16(f[4], f[5]); w.w = cvt_pk_bf16(f[6], f[7]);
          *(u32x4*)(dm + (size_t)n * 4096 + k8) = w; }
      bf16_t* dc = (bf16_t*)(ws + WS_DC);
      for (int e = blockIdx.x * NTHR + tid; e < 256 * 64; e += G * NTHR) { const int n = e >> 6, k8 = (e & 63) * 8; float f[8];
#pragma unroll
          for (int j = 0; j < 8; ++j) { const int kp = k8 + j; const int k = (kp & ~31) | (((kp >> 2) & 1) << 4) | (((kp >> 3) & 3) << 2) | (kp & 3); f[j] = (k < 256) ? tl[((n * k) & 255) * 8] : -tl[(((n * (k - 256)) & 255) * 8 + 1536) & 2047]; }
          u32x4 w; w.x = cvt_pk_bf16(f[0], f[1]); w.y = cvt_pk_bf16(f[2], f[3]); w.z = cvt_pk_bf16(f[4], f[5]); w.w = cvt_pk_bf16(f[6], f[7]);
          *(u32x4*)(dc + (size_t)n * 512 + k8) = w; } }
}
__device__ __forceinline__ void prep_b(const Params& p, unsigned char* ws, int G, int kwid) {
    const float* modpart = (const float*)(ws + WS_BIG + BIG_MODPART); float* mod = (float*)(ws + WS_MOD);
    for (int e = blockIdx.x * NTHR + lv(TIDX); e < 4 * 17 * 6144; e += G * NTHR) { const int n = e % 6144, l = e / (17 * 6144); float s = p.b_ada[l * 6144 + n];
#pragma unroll
        for (int kc = 0; kc < 8; ++kc) s += modpart[(size_t)kc * (4 * 17 * 6144) + e];
        mod[e] = s; }
}

#define MFMA16(a, b, c) __builtin_amdgcn_mfma_f32_16x16x32_bf16(a, b, c, 0, 0, 0)
constexpr float LOG2E = 1.4426950408889634f;
__device__ __forceinline__ bf16x8 mk8(u32x2 a, u32x2 b) { u32x4 w; w.x = a.x; w.y = a.y; w.z = b.x; w.w = b.y; return __builtin_bit_cast(bf16x8, w); }

__device__ __forceinline__ void diffattn_item(LAS unsigned char* lds, const bf16_t* proj, const bf16_t* vtb, bf16_t* brb, const float* subg, float lam, int post,
                              int b, int h, int qtok0, int kt0, int kt1, int kwid) {
    const int tid = lv(TIDX), wid = __builtin_amdgcn_readfirstlane(tid >> 6), lane = tid & 63, fr = lane & 15, fq = lane >> 4;
    const int sub = wid >> 2, qrow0 = qtok0 + (wid & 3) * 32;
    bf16x8 qf[2][2];
#pragma unroll
    for (int qt = 0; qt < 2; ++qt)
#pragma unroll
        for (int dh = 0; dh < 2; ++dh) qf[qt][dh] = *(const bf16x8*)(proj + (size_t)(qrow0 + qt * 16 + fr) * 2048 + h * 128 + sub * 64 + dh * 32 + fq * 8);
    f32x4 O[8][2];
#pragma unroll
    for (int et = 0; et < 8; ++et) { O[et][0] = (f32x4){0.f, 0.f, 0.f, 0.f}; O[et][1] = (f32x4){0.f, 0.f, 0.f, 0.f}; }
    float mrun[2] = {-1e30f, -1e30f}, lrun[2] = {0.f, 0.f};
    u32x4 kreg[4], vreg[4];
    const unsigned koff0 = (unsigned)((tid >> 4) * 2048 + (tid & 15) * 8) * 2u, voff0 = (unsigned)((tid >> 4) * 2304 + (tid & 15) * 8) * 2u;
#define DA_GLOAD(kt) do { const int _kr = (kt) < 16 ? b * 2048 + (kt) * 128 : MLAT + b * 256 + ((kt) - 16) * 128; \
        const char* _kb = (const char*)(proj + (size_t)_kr * 2048 + 512 + h * 128); const char* _vb = (const char*)(vtb + (size_t)(b * 512 + h * 128) * 2304 + (kt) * 128); \
        _Pragma("unroll") for (int _i = 0; _i < 4; ++_i) { \
        kreg[_i] = *(const u32x4*)(_kb + (size_t)_i * (32 * 2048 * 2) + (size_t)koff0); \
        vreg[_i] = *(const u32x4*)(_vb + (size_t)_i * (32 * 2304 * 2) + (size_t)voff0); } } while (0)
#define DA_LWRITE(kb) do { _Pragma("unroll") for (int _i = 0; _i < 4; ++_i) { const int ch = tid + 512 * _i; \
        *(LAS u32x4*)(lds + (kb) * 34816 + (ch >> 4) * 272 + (ch & 15) * 16) = kreg[_i]; \
        *(LAS u32x4*)(lds + 69632 + (kb) * 34816 + (ch >> 4) * 272 + (ch & 15) * 16) = vreg[_i]; } } while (0)
    __syncthreads();
    DA_GLOAD(kt0); DA_LWRITE(0); __syncthreads();
    for (int kt = kt0; kt < kt1; ++kt) {
        const int cur = (kt - kt0) & 1;
        if (kt + 1 < kt1) DA_GLOAD(kt + 1);
#pragma unroll
        for (int hk = 0; hk < 2; ++hk) {
        f32x4 S[4][2];
#pragma unroll
        for (int kq = 0; kq < 4; ++kq) { S[kq][0] = (f32x4){0.f, 0.f, 0.f, 0.f}; S[kq][1] = (f32x4){0.f, 0.f, 0.f, 0.f}; }
#pragma unroll
        for (int kq = 0; kq < 4; ++kq)
#pragma unroll
            for (int dh = 0; dh < 2; ++dh) { const bf16x8 kf = *(const LAS bf16x8*)(lds + cur * 34816 + (hk * 64 + kq * 16 + fr) * 272 + (sub * 64 + dh * 32 + fq * 8) * 2);
                S[kq][0] = MFMA16(kf, qf[0][dh], S[kq][0]); S[kq][1] = MFMA16(kf, qf[1][dh], S[kq][1]); }
        bf16x8 pb[2][2];
#pragma unroll
        for (int qt = 0; qt < 2; ++qt) {
            float mx = -1e30f;
#pragma unroll
            for (int kq = 0; kq < 4; ++kq)
#pragma unroll
                for (int j = 0; j < 4; ++j) mx = fmaxf(mx, S[kq][qt][j]);
            mx = fmaxf(mx, SHX(mx, 16)); mx = fmaxf(mx, SHX(mx, 32));
            const float mxs = mx * LOG2E; const float mnew = (mxs > mrun[qt] + 8.0f) ? mxs : mrun[qt]; const float alpha = __builtin_amdgcn_exp2f(mrun[qt] - mnew); mrun[qt] = mnew;
            f32x4 lsv = (f32x4){0.f, 0.f, 0.f, 0.f}; u32x2 pk[4];
#pragma unroll
            for (int kq = 0; kq < 4; ++kq) { const f32x4 t = S[kq][qt] * LOG2E - mnew; f32x4 pv;
#pragma unroll
                for (int j = 0; j < 4; ++j) pv[j] = __builtin_amdgcn_exp2f(t[j]);
                lsv += pv; pk[kq] = pack4(pv); }
            lrun[qt] = lrun[qt] * alpha + ((lsv[0] + lsv[1]) + (lsv[2] + lsv[3]));
            if (__builtin_amdgcn_ballot_w64(alpha != 1.0f) != 0ull) {
#pragma unroll
                for (int et = 0; et < 8; ++et) O[et][qt] *= alpha; }
            pb[qt][0] = mk8(pk[0], pk[1]); pb[qt][1] = mk8(pk[2], pk[3]);
        }
#pragma unroll
        for (int kc2 = 0; kc2 < 2; ++kc2)
#pragma unroll
            for (int et = 0; et < 8; ++et) { const bf16x8 vf = *(const LAS bf16x8*)(lds + 69632 + cur * 34816 + (et * 16 + fr) * 272 + (hk * 64 + kc2 * 32 + fq * 8) * 2);
                O[et][0] = MFMA16(vf, pb[0][kc2], O[et][0]); O[et][1] = MFMA16(vf, pb[1][kc2], O[et][1]); }
        }
        if (kt + 1 < kt1) DA_LWRITE(cur ^ 1);
        __syncthreads();
    }
#undef DA_GLOAD
#undef DA_LWRITE
#pragma unroll
    for (int qt = 0; qt < 2; ++qt) { float l = lrun[qt]; l += SHX(l, 16); l += SHX(l, 32); const float inv = 1.0f / l;
#pragma unroll
        for (int et = 0; et < 8; ++et) O[et][qt] *= inv; }
    if (sub == 1) {
#pragma unroll
        for (int qt = 0; qt < 2; ++qt)
#pragma unroll
            for (int et = 0; et < 8; ++et) *(LAS f32x4*)(lds + ((wid & 3) * 16 + qt * 8 + et) * 1024 + lane * 16) = O[et][qt]; }
    __syncthreads();
    if (sub == 0) {
#pragma unroll
        for (int qt = 0; qt < 2; ++qt) { float ss = 0.f;
#pragma unroll
            for (int et = 0; et < 8; ++et) { const f32x4 x1 = *(const LAS f32x4*)(lds + ((wid & 3) * 16 + qt * 8 + et) * 1024 + lane * 16); const f32x4 o = O[et][qt] - x1 * lam; O[et][qt] = o;
                ss += o[0] * o[0] + o[1] * o[1] + o[2] * o[2] + o[3] * o[3]; }
            ss += SHX(ss, 16); ss += SHX(ss, 32);
            const int li_ = post; const int pbits_ = lsg(li_ == 0 ? (int)0x3f4ccccdu : li_ == 1 ? (int)0x3f24fd5cu : li_ == 2 ? (int)0x3f077f5au : (int)0x3ee34c57u); const float postf = __int_as_float(pbits_);
            const float rstd = rsqrtf(ss * (1.0f / 128.0f) + 1e-5f) * postf;
            bf16_t* rp = brb + (size_t)(qrow0 + qt * 16 + fr) * 1536 + 512 + h * 128 + fq * 4;
#pragma unroll
            for (int et = 0; et < 8; ++et) { const f32x4 g = *(const f32x4*)(subg + et * 16 + fq * 4); *(u32x2*)(rp + et * 16) = pack4(O[et][qt] * rstd * g); } } }
    __syncthreads();
}

__device__ __forceinline__ void na_chunk(const LAS unsigned char* kb, const LAS unsigned char* vb, int vstride, int kbase, const bf16x8 (&qf)[2], f32x4 (&O)[4], float& mrun, float& lrun,
                                         int fr, int fq, bool usebias, const LAS float* rpbs, int rowidx0, const int (&dcoff)[8]) {
    const int lane = fq * 16 + fr;
    f32x4 S[4];
#pragma unroll
    for (int kq = 0; kq < 4; ++kq) { S[kq] = (f32x4){0.f, 0.f, 0.f, 0.f};
#pragma unroll
        for (int dh = 0; dh < 2; ++dh) { const bf16x8 kf = *(const LAS bf16x8*)(kb + (kbase + kq * 16 + fr) * 144 + (dh * 32 + fq * 8) * 2); S[kq] = MFMA16(kf, qf[dh], S[kq]); } }
    if (usebias) {
#pragma unroll
        for (int kq = 0; kq < 4; ++kq)
#pragma unroll
            for (int j = 0; j < 4; ++j) { const int dco = dcoff[(kq & 1) * 4 + j];
                const float bv = *(const LAS float*)((const LAS unsigned char*)rpbs + (rowidx0 + (kq >> 1)) * 124 + (dco < 0 ? 0 : dco)); S[kq][j] = dco >= 0 ? S[kq][j] + bv : -1e30f; } }
    float mx = -1e30f;
#pragma unroll
    for (int kq = 0; kq < 4; ++kq)
#pragma unroll
        for (int j = 0; j < 4; ++j) mx = fmaxf(mx, S[kq][j]);
    mx = fmaxf(mx, SHX(mx, 16)); mx = fmaxf(mx, SHX(mx, 32));
    const float mnew = fmaxf(mrun, mx * LOG2E); const float alpha = __builtin_amdgcn_exp2f(mrun - mnew); mrun = mnew;
    f32x4 lsv = (f32x4){0.f, 0.f, 0.f, 0.f}; u32x2 pk[4];
#pragma unroll
    for (int kq = 0; kq < 4; ++kq) { const f32x4 t = S[kq] * LOG2E - mnew; f32x4 pv;
#pragma unroll
        for (int j = 0; j < 4; ++j) pv[j] = __builtin_amdgcn_exp2f(t[j]);
        lsv += pv; pk[kq] = pack4(pv); }
    lrun = lrun * alpha + ((lsv[0] + lsv[1]) + (lsv[2] + lsv[3]));
    const bf16x8 pb0 = mk8(pk[0], pk[1]), pb1 = mk8(pk[2], pk[3]);
#pragma unroll
    for (int et = 0; et < 4; ++et) { O[et] *= alpha;
        const LAS unsigned char* vp = vb + (et * 16 + fr) * vstride + (kbase + fq * 4) * 2;
        O[et] = MFMA16(mk8(*(const LAS u32x2*)vp, *(const LAS u32x2*)(vp + 32)), pb0, O[et]);
        O[et] = MFMA16(mk8(*(const LAS u32x2*)(vp + 64), *(const LAS u32x2*)(vp + 96)), pb1, O[et]); }
}

__device__ __forceinline__ void na_item(LAS unsigned char* lds, const bf16_t* proj, const bf16_t* vtc, const float* rpbh, bf16_t* brb, int b, int h, int mode, int jblk, int band, int kwid) {
    const int tid = lv(TIDX), wid = __builtin_amdgcn_readfirstlane(tid >> 6), lane = tid & 63, fr = lane & 15, fq = lane >> 4;
    const int qtok = (mode == 0) ? b * 2048 + (band * 8 + wid) * 64 + jblk * 16 + fr : MLAT + b * 256 + band * 128 + wid * 16 + fr;
    bf16x8 qf[2];
#pragma unroll
    for (int dh = 0; dh < 2; ++dh) qf[dh] = *(const bf16x8*)(proj + (size_t)qtok * 2048 + 1024 + h * 64 + dh * 32 + fq * 8);
    f32x4 O[4];
#pragma unroll
    for (int et = 0; et < 4; ++et) O[et] = (f32x4){0.f, 0.f, 0.f, 0.f};
    float mrun = -1e30f, lrun = 0.f;
    LAS float* rpbs = (LAS float*)(lds + 133120);
    __syncthreads();
#pragma unroll
    for (int i = 0; i < 4; ++i) { const int ch = tid + 512 * i; const int key = ch >> 3, c16 = ch & 7;
        *(LAS u32x4*)(lds + key * 144 + c16 * 16) = *(const u32x4*)(proj + (size_t)(MLAT + b * 256 + key) * 2048 + 1536 + h * 64 + c16 * 8);
        const int e = ch >> 5, d16 = ch & 31;
        *(LAS u32x4*)(lds + 36864 + e * 528 + d16 * 16) = *(const u32x4*)(vtc + (size_t)(b * 512 + h * 64 + e) * 2304 + 2048 + d16 * 8); }
    if (mode == 0) for (int e = tid; e < 465; e += NTHR) rpbs[e] = rpbh[e];
    const int rfirst = band * 8; const int R0 = min(max(rfirst - 4, 0), 24), nrows = min(max(rfirst + 7 - 4, 0), 24) + 8 - R0; const int kc0 = min(max(16 * jblk - 8, 0), 32);
    const int per_e = nrows * 4;
    int dcoff[8];
    { const int qcol_ = jblk * 16 + fr; const int c0_ = min(max(qcol_ - 8, 0), 48);
#pragma unroll
      for (int t = 0; t < 8; ++t) { const int kcol = kc0 + (t >> 2) * 16 + fq * 4 + (t & 3); const bool ok = (kcol >= c0_) && (kcol < c0_ + 16); const int dc = min(max(kcol - qcol_ + 15, 0), 30); dcoff[t] = ok ? dc * 4 : -1; } }
    u32x4 kl[8], vl[8];
    if (mode == 0) {
#pragma unroll
        for (int i = 0; i < 8; ++i) { const int ch = tid + 512 * i;
            if (ch < nrows * 256) { const int key = ch >> 3, c16 = ch & 7; const int il = key >> 5, w = key & 31;
                kl[i] = *(const u32x4*)(proj + (size_t)(b * 2048 + (R0 + il) * 64 + kc0 + w) * 2048 + 1536 + h * 64 + c16 * 8); }
            if (ch < 64 * per_e) { const int e = ch / per_e, rem = ch - e * per_e; const int il = rem >> 2, c16 = rem & 3;
                vl[i] = *(const u32x4*)(vtc + (size_t)(b * 512 + h * 64 + e) * 2304 + (R0 + il) * 64 + kc0 + c16 * 8); } }
    }
    __syncthreads();
#pragma unroll 1
    for (int c = 0; c < 4; ++c) na_chunk(lds, lds + 36864, 528, c * 64, qf, O, mrun, lrun, fr, fq, false, rpbs, 0, dcoff);
    if (mode == 0) {
        __syncthreads();
#pragma unroll
        for (int i = 0; i < 8; ++i) { const int ch = tid + 512 * i;
            if (ch < nrows * 256) { const int key = ch >> 3, c16 = ch & 7; *(LAS u32x4*)(lds + key * 144 + c16 * 16) = kl[i]; }
            if (ch < 64 * per_e) { const int e = ch / per_e, rem = ch - e * per_e; const int il = rem >> 2, c16 = rem & 3; *(LAS u32x4*)(lds + 69120 + e * 976 + (il * 32 + c16 * 8) * 2) = vl[i]; } }
        __syncthreads();
        const int r = band * 8 + wid; const int r0 = min(max(r - 4, 0), 24); const int ilb = r0 - R0; const int qcol = jblk * 16 + fr;
#pragma unroll 1
        for (int c = 0; c < 4; ++c) na_chunk(lds, lds + 69120, 976, (ilb + 2 * c) * 32, qf, O, mrun, lrun, fr, fq, true, rpbs, r0 + 2 * c - r + 7, dcoff);
    }
    float l = lrun; l += SHX(l, 16); l += SHX(l, 32); const float inv = 1.0f / l;
    bf16_t* rp = brb + (size_t)qtok * 1536 + 1024 + h * 64 + fq * 4;
#pragma unroll
    for (int et = 0; et < 4; ++et) *(u32x2*)(rp + et * 16) = pack4(O[et] * inv);
    __syncthreads();
}


#define XB_TMO      128
#define XB_XCNT(j)  (256  + 64 * (j))
#define XB_XSUB(j)  (1280 + 64 * (j))
#define XB_XGEN(j)  (2304 + 64 * (j))
#define XB_TOP      3328
#define XB_TOPGEN   3392
#define XCD_BAR_WORDS 3456
#define XB_SPIN_CAP (1u << 22)
__device__ __forceinline__ unsigned xb_ld(unsigned* p)              { return __hip_atomic_load(p, __ATOMIC_RELAXED, __HIP_MEMORY_SCOPE_AGENT); }
__device__ __forceinline__ unsigned xb_add(unsigned* p, unsigned v) { return __hip_atomic_fetch_add(p, v, __ATOMIC_RELAXED, __HIP_MEMORY_SCOPE_AGENT); }
__device__ __forceinline__ unsigned xb_xcc_id() { return (unsigned)__builtin_amdgcn_s_getreg((3 << 11) | 20) & 0xFu; }
#define XB_SPIN(cond, bar) do { unsigned _sp = 0; while (cond) { __builtin_amdgcn_s_sleep(1); \
    if ((++_sp & 255u) == 0u) { if (xb_ld(&(bar)[XB_TMO])) break; if (_sp > XB_SPIN_CAP) { atomicAdd(&(bar)[XB_TMO], 1u); break; } } } } while (0)
__device__ __forceinline__ void xcd_barrier_complete(unsigned* bar, unsigned x, unsigned G, unsigned& nloc, unsigned& nx) {
    unsigned sum, cnt, mine, sp = 0u;
    for (;;) {
        sum = 0u; cnt = 0u; mine = 0u;
#pragma unroll
        for (unsigned j = 0; j < 16; ++j) { const unsigned c = xb_ld(&bar[XB_XCNT(j)]); sum += c; cnt += (c > 0u) ? 1u : 0u; mine = (j == x) ? c : mine; }
        if (sum == G) break;
        __builtin_amdgcn_s_sleep(1);
        if ((++sp & 255u) == 0u) { if (xb_ld(&bar[XB_TMO])) break; if (sp > XB_SPIN_CAP) { atomicAdd(&bar[XB_TMO], 1u); break; } }
    }
    nloc = mine > 0u ? mine : 1u; nx = cnt > 0u ? cnt : 1u;
}
__device__ __forceinline__ void xcd_barrier(unsigned* bar, volatile LAS unsigned* st, unsigned G, int kwid) {
    asm volatile("s_waitcnt vmcnt(0)" ::: "memory");
    __syncthreads();
    if (TIDX == 0) {
        __builtin_amdgcn_s_waitcnt(0);
        const unsigned x = xb_xcc_id();
        unsigned nloc = st[0], nx = st[1];
        if (nloc == 0u) { xcd_barrier_complete(bar, x, G, nloc, nx); st[0] = nloc; st[1] = nx; }
        const unsigned old = xb_add(&bar[XB_XSUB(x)], 1u);
        const unsigned gen = old / nloc;
        if (old + 1u == (gen + 1u) * nloc) {
            __builtin_amdgcn_fence(__ATOMIC_RELEASE, "agent");
            asm volatile("s_waitcnt vmcnt(0)" ::: "memory");
            const unsigned og = xb_add(&bar[XB_TOP], 1u);
            const unsigned tg = og / nx;
            if (og + 1u == (tg + 1u) * nx) xb_add(&bar[XB_TOPGEN], 1u);
            else XB_SPIN(xb_ld(&bar[XB_TOPGEN]) == tg, bar);
            __builtin_amdgcn_fence(__ATOMIC_ACQUIRE, "agent");
            xb_add(&bar[XB_XGEN(x)], 1u);
            asm volatile("s_waitcnt vmcnt(0)" ::: "memory");
        } else {
            XB_SPIN(xb_ld(&bar[XB_XGEN(x)]) == gen, bar);
            __builtin_amdgcn_fence(__ATOMIC_ACQUIRE, "agent");
            asm volatile("s_waitcnt vmcnt(0)" ::: "memory");
        }
    }
    __syncthreads();
}

#ifdef REPEAT_S
constexpr int NPHASE = 2 + 10 * DEPTH + 1;
#else
constexpr int NPHASE = 2 + 9 * DEPTH + 1;
#endif
#ifndef EN
#define EN 0xFFFF
#endif
#define ON(k) ((EN >> (k)) & 1)
__global__ void __launch_bounds__(NTHR) mega(Params p_in, int ph_lo, int ph_hi) {
    extern __shared__ __attribute__((aligned(16))) unsigned char smem[];
    LAS unsigned char* lds = (LAS unsigned char*)smem;
    float* tl = (float*)smem;
    const int kwid = __builtin_amdgcn_readfirstlane((int)threadIdx.x >> 6);
    cg::grid_group grid = cg::this_grid();
    volatile LAS unsigned* xst = (volatile LAS unsigned*)(lds + LDS_BYTES - 16);
    { unsigned* bar0 = (unsigned*)(p_in.ws + WS_BAR); if (TIDX == 0) { xst[0] = 0u; xst[1] = 0u; (void)xb_add(&bar0[XB_XCNT(xb_xcc_id())], 1u); } __syncthreads(); }
    for (int ph = ph_lo; ph < ph_hi; ++ph) {
        const int G = lsg((int)gridDim.x), c = lsg((int)blockIdx.x);
        const Params& p = p_in; unsigned char* ws = lptr(p_in.ws); float* outp = lptr(p_in.out);
        const float* mod = (const float*)(ws + WS_MOD);
        bf16_t* abuf = (bf16_t*)(ws + WS_ABUF); bf16_t* brb = (bf16_t*)(ws + WS_BR);
        float* hc = (float*)(ws + WS_HC);
        unsigned char* big = ws + WS_BIG;
        if (ph == 0) { if (ON(0)) prep_a(p, ws, tl, G, kwid); }
        else if (ph == 1) { if (ON(0)) prep_b(p, ws, G, kwid); }
        else if (ph == NPHASE - 1) final_norm(outp, p.g_final, G, kwid);
        else {
#ifdef REPEAT_S
            const int l = (ph - 2) / 10, s_ = (ph - 2) % 10; const int s = (s_ <= REPEAT_S) ? s_ : s_ - 1;
#define PROBE_NOSTORE ((s_ == REPEAT_S + 1) ? 1 : 0)
#else
            const int l = (ph - 2) / 9, s = (ph - 2) % 9;
#define PROBE_NOSTORE 0
#endif
            const float* modl = mod + (size_t)l * 17 * 6144;
            const bool lastl = (l == DEPTH - 1); const int nMl = lastl ? 128 : 144;
            const float* hx_in = (l == 0) ? p.x : outp; const float* hc_in = (l == 0) ? p.ctx : hc;
            const bool slack = !lastl && G > 64; const int swg = slack ? c - 64 : c, snw = slack ? G - 64 : G;
            if (s == 0) { if (l == 0) { conv_run(p, ws, l, 0, 768, tl, c, G, kwid); conv_win_fold(p, ws, l, tl, c, G, kwid); } norm_phase(hx_in, hc_in, p.g_mix + l * 1024, modl, 0, 1, abuf, G, MTOT, kwid); }
            else if (s == 1) { PolInProj pol{(const char*)abuf, (const char*)(ws + WS_WB), (bf16_t*)(big + BIG_PROJ), (bf16_t*)(big + BIG_T), (bf16_t*)(big + BIG_TC), (bf16_t*)(big + BIG_VTB), (bf16_t*)(big + BIG_VTC), lds + 131072, G, c, PROBE_NOSTORE};
                { const int t_ = lv(TIDX); const float* rope = (const float*)(ws + WS_ROPE); for (int e = t_; e < 2048; e += NTHR) *(LAS float*)(lds + 131072 + e * 4) = rope[e]; __syncthreads(); }
                gemm_run(lds, pol, kwid); }
            else if (s == 2) {
                conv_run(p, ws, l, 1, 1408, tl, c, G, kwid);
                { PolDft pol{(const char*)(ws + WS_DMAT), (const char*)(ws + WS_DC), (const char*)(big + BIG_T), (const char*)(big + BIG_TC), brb, G, c, lastl ? 256 : 288}; gemm_run(lds, pol, kwid); }
                const bf16_t* proj = (const bf16_t*)(big + BIG_PROJ);
                const float lam = __int_as_float(__builtin_amdgcn_readfirstlane(__float_as_int(((const float*)(ws + WS_LAM))[l]))); const int post = l;
                for (long L = c; L < (lastl ? 1024 : 1024 + 128); L += G) {
                    int b_, h_, q0_, k0_;
                    if (L < 1024) { const int rr = (int)L >> 8, cc = (int)L & 255; const int pair = rr * 16 + (cc & 7) * 2 + (cc >> 7), qb = (cc >> 3) & 15; b_ = pair >> 2; h_ = pair & 3; q0_ = b_ * 2048 + qb * 128; k0_ = 0; }
                    else { const int j = (int)L - 1024; b_ = j >> 3; h_ = (j >> 1) & 3; q0_ = MLAT + b_ * 256 + (j & 1) * 128; k0_ = 16; }
                    diffattn_item(lds, proj, (const bf16_t*)(big + BIG_VTB), brb, p.subln_g + l * 128, lam, post, b_, h_, q0_, k0_, 18, kwid); }
                for (long L = c; L < (lastl ? 2048 : 2048 + 256); L += G) {
                    int b_, h_, mode_, j_, band_;
                    if (L < 2048) { const int rr = (int)L >> 8, cc = (int)L & 255; const int pair = rr * 16 + (cc & 7) * 2 + (cc >> 7), sub = (cc >> 3) & 15; b_ = pair >> 3; h_ = pair & 7; mode_ = 0; j_ = sub & 3; band_ = sub >> 2; }
                    else { const int j = (int)L - 2048; b_ = j >> 4; h_ = (j >> 1) & 7; mode_ = 1; j_ = 0; band_ = j & 1; }
                    na_item(lds, proj, (const bf16_t*)(big + BIG_VTC), p.rpb + (size_t)(l * 8 + h_) * 465, brb, b_, h_, mode_, j_, band_, kwid); }
            }
            else if (s == 3) { PolMerge pol{(const char*)abuf, (const char*)brb, (const char*)(ws + WS_WB), p.b_gate + l * 3072, (u32x4*)(big + BIG_GSCR), (f32x4*)(big + BIG_SSCR), (bf16_t*)(big + BIG_MERGED), G, c, nMl}; gemm_run(lds, pol, kwid);
                conv_run(p, ws, l, 2, 1408, tl, swg, snw, kwid); conv_run(p, ws, l, 3, 704, tl, swg, snw, kwid); }
            else if (s == 4) { PolResid pol{(const char*)(big + BIG_MERGED), 2048, (const char*)(ws + WS_WB + 9437184), 2048, 16, hx_in, outp, hc_in, hc, modl, 2, G, c, nMl}; gemm_run(lds, pol, kwid); }
            else if (s == 5) { norm_phase(outp, hc, p.g_ffn + l * 1024, modl, 3, 4, abuf, G, lastl ? MLAT : MTOT, kwid); }
            else if (s == 6) { PolUp pol{(const char*)abuf, (const char*)(big + BIG_WUP), p.conv_w + (size_t)l * 3 * 5632, p.conv_b + (size_t)l * 5632, (bf16_t*)(big + BIG_GATED), (bf16_t*)(big + BIG_HB), G, c, nMl, lds + 131072}; gemm_run(lds, pol, kwid); }
            else if (s == 7) { fixup_phase((const bf16_t*)(big + BIG_HB), p.conv_w + (size_t)l * 3 * 5632, p.conv_b + (size_t)l * 5632, (bf16_t*)(big + BIG_GATED), G, lastl ? 512 : 576, kwid); }
            else { PolResid pol{(const char*)(big + BIG_GATED), 5632, (const char*)(big + BIG_WDOWN), 5632, 44, outp, outp, hc, hc, modl, 5, G, c, nMl}; gemm_run(lds, pol, kwid);
                if (!lastl) { conv_run(p, ws, l + 1, 0, 768, tl, swg, snw, kwid); conv_win_fold(p, ws, l + 1, tl, swg, snw, kwid); } }
        }
        if (ph + 1 < ph_hi) {
            if (ph_lo < 0) { __threadfence(); grid.sync(); }
            xcd_barrier((unsigned*)(ws + WS_BAR), xst, (unsigned)G, kwid);
        }
    }
}

extern "C" void kernel_launch(void* const* d_in, const int* in_sizes, int n_in, void* d_out, int out_size, void* d_ws, size_t ws_size, hipStream_t stream) {
    static int grid_blocks = 0;
    if (grid_blocks == 0) {
        if (n_in != 22 || ws_size < WS_END) { fprintf(stderr, "kernel_launch: unexpected n_in %d or ws_size %zu (need %zu)\n", n_in, ws_size, (size_t)WS_END); grid_blocks = -1; return; }
        if (hipFuncSetAttribute((const void*)mega, hipFuncAttributeMaxDynamicSharedMemorySize, LDS_BYTES) != hipSuccess) { fprintf(stderr, "hipFuncSetAttribute failed\n"); grid_blocks = -1; return; }
        int dev = 0, cus = 0, per_cu = 0;
        hipGetDevice(&dev); hipDeviceGetAttribute(&cus, hipDeviceAttributeMultiprocessorCount, dev);
        hipOccupancyMaxActiveBlocksPerMultiprocessor(&per_cu, (const void*)mega, NTHR, LDS_BYTES);
        if (per_cu < 1) { fprintf(stderr, "occupancy query says %d blocks/CU\n", per_cu); per_cu = 1; }
        (void)hipGetLastError();
        grid_blocks = cus;
    }
    if (grid_blocks < 0) return;
    if (hipMemsetAsync((char*)d_ws + WS_BAR, 0, 16384, stream) != hipSuccess) { fprintf(stderr, "memset failed\n"); return; }
    Params p{};
    const float** pp = (const float**)&p;
    for (int i = 0; i < 22; ++i) pp[i] = (const float*)d_in[i];
    p.out = (float*)d_out; p.ws = (unsigned char*)d_ws;
    int lo = 0, hi = NPHASE;
    void* args[] = {&p, &lo, &hi};
    hipError_t e = hipLaunchCooperativeKernel((const void*)mega, dim3(grid_blocks), dim3(NTHR), args, LDS_BYTES, stream);
    if (e != hipSuccess) fprintf(stderr, "cooperative launch failed: %s (grid %d)\n", hipGetErrorString(e), grid_blocks);
}
```

```cpp
#include <hip/hip_runtime.h>
#include <hip/hip_cooperative_groups.h>
#include <cstdio>
namespace cg = cooperative_groups;

#define LAS __attribute__((address_space(3)))
__device__ __forceinline__ int mytid_(int kwid) { int z = 0; asm volatile("" : "+v"(z)); return kwid * 64 + (int)__builtin_amdgcn_mbcnt_hi(~0u, __builtin_amdgcn_mbcnt_lo(~0u, (unsigned)z)); }
#define TIDX mytid_(kwid)
typedef unsigned short bf16_t;
typedef short bf16x8 __attribute__((ext_vector_type(8)));
typedef float f32x4 __attribute__((ext_vector_type(4)));
typedef unsigned u32x4 __attribute__((ext_vector_type(4)));
typedef unsigned u32x2 __attribute__((ext_vector_type(2)));

constexpr int D = 1024, NB = 16, SEQ = 2048, CTXL = 256, DEPTH = 4;
constexpr int MLAT = NB * SEQ, MCTX = NB * CTXL, MTOT = MLAT + MCTX;
constexpr int DFF = 2816, PROJW = 6656;
constexpr int NTHR = 512;
constexpr int LDS_BYTES = 147456;

constexpr size_t WS_WB = 0;
constexpr size_t WB_BYTES = 11534336;
constexpr size_t WS_DMAT = WS_WB + WB_BYTES;
constexpr size_t WS_DC = WS_DMAT + 16777216;
constexpr size_t WS_HC = WS_DC + 262144;
constexpr size_t WS_MOD = WS_HC + 16777216;
constexpr size_t WS_ROPE = WS_MOD + 1671168;
constexpr size_t WS_LAM = WS_ROPE + 8192;
constexpr size_t WS_ABUF = WS_LAM + 256;
constexpr size_t WS_BR = WS_ABUF + 75497472;
constexpr size_t WS_BIG = WS_BR + 113246208;
constexpr size_t BIG_PROJ = 0;
constexpr size_t BIG_T = 150994944;
constexpr size_t BIG_TC = BIG_T + 67108864;
constexpr size_t BIG_VTB = BIG_TC + 8388608;
constexpr size_t BIG_VTC = BIG_VTB + 37748736;
constexpr size_t BIG_BYTES = BIG_VTC + 37748736;
constexpr size_t BIG_MERGED = 0;
constexpr size_t BIG_GSCR = 75497472;
constexpr size_t BIG_SSCR = BIG_GSCR + 33554432;
constexpr size_t BIG_GATED = 0;
constexpr size_t BIG_HB = 207618048;
constexpr size_t BIG_WUP = 233570304;
constexpr size_t BIG_WDOWN = BIG_WUP + 11534336;
static_assert(BIG_WDOWN + 5767168 <= BIG_BYTES, "big");
constexpr size_t BIG_MODPART = 0;
constexpr size_t WS_BAR = WS_BIG + BIG_BYTES;
constexpr size_t WS_END = WS_BAR + 16384;
static_assert(WS_END <= 541745280ull, "workspace");

struct Params {
    const float *x, *c, *ctx, *c_ctx, *w_ada, *b_ada, *g_mix, *g_ffn, *w_in, *b_gate, *w_a, *lam, *subln_g, *w_b, *rpb, *w_c, *w_out, *w_up, *conv_w, *conv_b, *w_down, *g_final;
    float* out; unsigned char* ws;
};

__device__ __forceinline__ unsigned cvt_pk_bf16(float lo, float hi) { unsigned r; asm volatile("v_cvt_pk_bf16_f32 %0, %1, %2" : "=v"(r) : "v"(lo), "v"(hi)); return r; }
__device__ __forceinline__ int lv(int x) { asm volatile("" : "+v"(x)); return x; }
__device__ __forceinline__ int lsg(int x) { asm volatile("" : "+s"(x)); return x; }
__device__ __forceinline__ float bperm(float v, int srclane) { return __int_as_float(__builtin_amdgcn_ds_bpermute(srclane << 2, __float_as_int(v))); }
template <class T> __device__ __forceinline__ T* lptr(T* x) { asm volatile("" : "+s"(x)); return x; }
__device__ __forceinline__ float bf2f(unsigned short b) { return __uint_as_float(((unsigned)b) << 16); }
__device__ __forceinline__ u32x2 pack4(f32x4 v) { u32x2 w; w.x = cvt_pk_bf16(v[0], v[1]); w.y = cvt_pk_bf16(v[2], v[3]); return w; }
__device__ __forceinline__ f32x4 unpack4(u32x2 w) { f32x4 v; v[0] = __uint_as_float(w.x << 16); v[1] = __uint_as_float(w.x & 0xffff0000u); v[2] = __uint_as_float(w.y << 16); v[3] = __uint_as_float(w.y & 0xffff0000u); return v; }

constexpr int HTB = 128 * 64 * 2;
__device__ __forceinline__ int lds_byte(int r, int c) { const int st = (r >> 4) * 2 + (c >> 5), rr = r & 15, cc = c & 31, ob = rr * 64 + cc * 2; return st * 1024 + (ob ^ (((ob >> 9) & 1) << 5)); }
__device__ __forceinline__ void stage_rc(int b, int& R, int& C) { const int st = b / 1024, sb = b % 1024, swz = sb ^ (((sb >> 9) & 1) << 5); R = (st >> 1) * 16 + swz / 64; C = (st & 1) * 32 + (swz % 64) / 2; }

struct UnitD { const char* A; const char* B; int lda, ldb, nt; int pm, pn, kind, br; };

__device__ __forceinline__ bool tile_order(long L, int nM, int nN, int& pm, int& pn) {
    const int nwg = nM * nN; if (L >= nwg) return false;
    int wgid = (int)L; { const int q = nwg / 8, r = nwg % 8, xcd = wgid % 8, off = wgid / 8; wgid = (xcd < r ? xcd * (q + 1) : r * (q + 1) + (xcd - r) * q) + off; }
    const int nig = 8 * nN, gid = wgid / nig, fm = gid * 8, gsz = (nM - fm) < 8 ? (nM - fm) : 8;
    pm = fm + ((wgid % nig) % gsz); pn = (wgid % nig) / gsz; return true;
}

template <class P>
__device__ __forceinline__ void gemm_run(LAS unsigned char* lds, const P& pol, int kwid) {
    const int tid = lv(TIDX), wid = __builtin_amdgcn_readfirstlane(tid >> 6), lane = tid & 63, wr = wid >> 2, wc = wid & 3, fr = lane & 15, fq = lane >> 4;
    int R0_, C0_; { int R, C; stage_rc(tid * 16, R, C); R0_ = R; C0_ = C * 2; }
    const unsigned ldsw = (unsigned)wid * 1024u;
    const int aoff = lds_byte(wr * 64 + fr, fq * 8), boff = lds_byte(wc * 32 + fr, fq * 8);
#define G_SA(b, h) (((b) * 2 + (h)) * HTB)
#define G_SB(b, h) ((4 + (b) * 2 + (h)) * HTB)
#define G_STAGE(bufoff, gbase, ld) do { const unsigned _vo = (unsigned)(R0_ * (ld) + C0_); \
        __builtin_amdgcn_global_load_lds((const unsigned*)((const char*)(gbase) + _vo), (LAS unsigned*)(lds + (bufoff) + ldsw), 16, 0, 0); \
        __builtin_amdgcn_global_load_lds((const unsigned*)((const char*)(gbase) + 64 * (ld) + _vo), (LAS unsigned*)(lds + (bufoff) + ldsw + 8192), 16, 0, 0); } while (0)
#define G_LDA(dst, b, h) do { _Pragma("unroll") for (int m = 0; m < 4; ++m) _Pragma("unroll") for (int k = 0; k < 2; ++k) dst[m][k] = *(const LAS bf16x8*)(lds + G_SA(b, h) + aoff + m * 2048 + k * 1024); } while (0)
#define G_LDB(dst, b, h) do { _Pragma("unroll") for (int n = 0; n < 2; ++n) _Pragma("unroll") for (int k = 0; k < 2; ++k) dst[n][k] = *(const LAS bf16x8*)(lds + G_SB(b, h) + boff + n * 2048 + k * 1024); } while (0)
#define G_MMA(ai, bj, At, Bt) do { __builtin_amdgcn_s_setprio(1); _Pragma("unroll") for (int m = 0; m < 4; ++m) _Pragma("unroll") for (int n = 0; n < 2; ++n) _Pragma("unroll") for (int k = 0; k < 2; ++k) \
        acc[ai][bj][m][n] = __builtin_amdgcn_mfma_f32_16x16x32_bf16(Bt[n][k], At[m][k], acc[ai][bj][m][n], 0, 0, 0); __builtin_amdgcn_s_setprio(0); } while (0)
#define G_WAIT_V(n) asm volatile("s_waitcnt vmcnt(" #n ")" ::: "memory")
#define G_WAIT_L(n) asm volatile("s_waitcnt lgkmcnt(" #n ")" ::: "memory")
#define G_BAR __builtin_amdgcn_s_barrier()
#define G_SCHED __builtin_amdgcn_sched_barrier(0)
    UnitD cur, nxt; int ui = 0;
    if (!pol.unit(0, cur)) return;
    f32x4 acc[2][2][4][2];
#pragma unroll
    for (int a = 0; a < 2; ++a)
#pragma unroll
        for (int b = 0; b < 2; ++b)
#pragma unroll
            for (int m = 0; m < 4; ++m)
#pragma unroll
                for (int n = 0; n < 2; ++n) acc[a][b][m][n] = (f32x4){0.f, 0.f, 0.f, 0.f};
    bf16x8 At[4][2], B0[2][2], B1[2][2];
    const char* cA = cur.A; const char* cB = cur.B; int lda = cur.lda, ldb = cur.ldb;
    G_STAGE(G_SB(0, 0), cB, ldb); G_STAGE(G_SA(0, 0), cA, lda); G_STAGE(G_SB(0, 1), cB + 128 * ldb, ldb); G_STAGE(G_SA(0, 1), cA + 128 * lda, lda);
    if (wr == 1) G_BAR;
    G_WAIT_V(4); G_BAR;
    G_STAGE(G_SB(1, 0), cB + 128, ldb); G_STAGE(G_SA(1, 0), cA + 128, lda); G_STAGE(G_SB(1, 1), cB + 128 * ldb + 128, ldb);
    G_WAIT_V(6); G_BAR;
    for (;;) {
        const bool has_next = pol.unit(ui + 1, nxt);
        const char* nA = has_next ? nxt.A : cA; const char* nB = has_next ? nxt.B : cB;
        const int nlda = has_next ? nxt.lda : lda, nldb = has_next ? nxt.ldb : ldb;
        const int nt = cur.nt;
        for (int t = 0; t < nt; t += 2) {
            const bool last = (t == nt - 2);
            const char* a1 = cA + (size_t)(t + 1) * 128;
            const char* a2 = last ? nA : cA + (size_t)(t + 2) * 128; const char* b2 = last ? nB : cB + (size_t)(t + 2) * 128;
            const int la2 = last ? nlda : lda, lb2 = last ? nldb : ldb;
            const char* a3 = a2 + 128; const char* b3 = b2 + 128;
            G_LDB(B0, 0, 0); G_SCHED; G_LDA(At, 0, 0); G_STAGE(G_SA(1, 1), a1 + 128 * lda, lda);
            G_WAIT_L(8); G_BAR; G_WAIT_L(0); G_MMA(0, 0, At, B0); G_BAR; G_SCHED;
            G_LDB(B1, 0, 1); G_STAGE(G_SB(0, 0), b2, lb2);
            G_BAR; G_WAIT_L(0); G_MMA(0, 1, At, B1); G_BAR;
            G_LDA(At, 0, 1); G_STAGE(G_SA(0, 0), a2, la2);
            G_BAR; G_WAIT_L(0); G_MMA(1, 0, At, B0); G_BAR; G_SCHED;
            G_STAGE(G_SB(0, 1), b2 + 128 * lb2, lb2);
            G_WAIT_V(6); G_BAR; G_MMA(1, 1, At, B1); G_BAR;
            G_LDB(B0, 1, 0); G_SCHED; G_LDA(At, 1, 0); G_STAGE(G_SA(0, 1), a2 + 128 * la2, la2);
            G_WAIT_L(8); G_BAR; G_WAIT_L(0); G_MMA(0, 0, At, B0); G_BAR; G_SCHED;
            G_LDB(B1, 1, 1); G_STAGE(G_SB(1, 0), b3, lb2);
            G_BAR; G_WAIT_L(0); G_MMA(0, 1, At, B1); G_BAR;
            G_LDA(At, 1, 1); G_STAGE(G_SA(1, 0), a3, la2);
            G_BAR; G_WAIT_L(0); G_MMA(1, 0, At, B0); G_BAR; G_SCHED;
            G_STAGE(G_SB(1, 1), b3 + 128 * lb2, lb2);
            G_WAIT_V(6); G_BAR; G_MMA(1, 1, At, B1); G_BAR;
        }
        { const int t2 = lv(TIDX); pol.epi(acc, cur, wr, wc, t2 & 15, (t2 >> 4) & 3, t2); }
        if (!has_next) break;
#pragma unroll
        for (int a = 0; a < 2; ++a)
#pragma unroll
            for (int b = 0; b < 2; ++b)
#pragma unroll
                for (int m = 0; m < 4; ++m)
#pragma unroll
                    for (int n = 0; n < 2; ++n) acc[a][b][m][n] = (f32x4){0.f, 0.f, 0.f, 0.f};
        cur = nxt; cA = nA; cB = nB; lda = nlda; ldb = nldb; ++ui;
    }
    G_WAIT_V(0);
    if (wr == 0) G_BAR;
    G_BAR;
#undef G_SA
#undef G_SB
#undef G_STAGE
#undef G_LDA
#undef G_LDB
#undef G_MMA
}

__device__ __forceinline__ f32x4 sel4(bool c, f32x4 a, f32x4 b) { f32x4 r; r[0] = c ? a[0] : b[0]; r[1] = c ? a[1] : b[1]; r[2] = c ? a[2] : b[2]; r[3] = c ? a[3] : b[3]; return r; }
__device__ __forceinline__ f32x4 ldg4(const void* base, unsigned off) { return *(const f32x4*)((const char*)base + (size_t)off); }
__device__ __forceinline__ void stg2(void* base, unsigned off, u32x2 v) { *(u32x2*)((char*)base + (size_t)off) = v; }
typedef f32x4 Acc[2][2][4][2];

struct PolInProj {
    const char* abuf; const char* wt; bf16_t* proj; bf16_t* T; bf16_t* Tc; bf16_t* VtB; bf16_t* VtC; const LAS unsigned char* ropel; int G, c; int nostore;
    __device__ __forceinline__ bool unit(int i, UnitD& u) const {
        int pm, pn; if (!tile_order((long)i * G + c, 144, 16, pm, pn)) return false;
        u.pm = pm; u.pn = pn; u.lda = 2048; u.ldb = 2048; u.nt = 16; u.br = 0;
        const bool sw = (pn < 4) || (pn >= 12); u.kind = sw ? 1 : 0;
        const char* act = abuf + (size_t)pm * 256 * 2048; const char* w = wt + (size_t)pn * 256 * 2048;
        u.A = sw ? w : act; u.B = sw ? act : w; return true;
    }
    __device__ __forceinline__ void epi(Acc& acc, const UnitD& u, int wr, int wc, int fr, int fq, int tid) const {
        const int pm = u.pm, pn = u.pn;
        if (nostore) { float sink = 0.f; for (int a = 0; a < 2; ++a) for (int b = 0; b < 2; ++b) for (int m = 0; m < 4; ++m) for (int n = 0; n < 2; ++n) sink += acc[a][b][m][n][0] + acc[a][b][m][n][1] + acc[a][b][m][n][2] + acc[a][b][m][n][3]; if (sink == 123.456f) proj[0] = 0; return; }
        if (u.kind) {
            const bool lat = pm < 128; const int b = lat ? (pm >> 3) : (pm - 128);
            bf16_t* base; int rowlen;
            if (pn < 4) { const int part = pn >> 1, col0 = (pn & 1) * 256;
                if (lat) { base = T + ((size_t)(b * 512 + col0) * 4096 + part * 2048 + (pm & 7) * 256); rowlen = 4096; }
                else { base = Tc + ((size_t)(b * 512 + col0) * 512 + part * 256); rowlen = 512; } }
            else { bf16_t* vt = (pn < 14) ? VtB : VtC; const int col0 = (pn & 1) * 256;
                base = vt + ((size_t)(b * 512 + col0) * 2304 + (lat ? (pm & 7) * 256 : 2048)); rowlen = 2304; }
            if (pn < 14) {
#pragma unroll
                for (int ai = 0; ai < 2; ++ai)
#pragma unroll
                    for (int m = 0; m < 4; ++m) { const int r = ai * 128 + wr * 64 + m * 16 + fr; bf16_t* rp = base + (size_t)r * rowlen + wc * 32 + 8 * fq;
#pragma unroll
                        for (int bj = 0; bj < 2; ++bj) { const u32x2 p0 = pack4(acc[ai][bj][m][0]), p1 = pack4(acc[ai][bj][m][1]); u32x4 w; w.x = p0.x; w.y = p0.y; w.z = p1.x; w.w = p1.y; *(u32x4*)(rp + bj * 128) = w; } }
            } else {
#pragma unroll
                for (int ai = 0; ai < 2; ++ai)
#pragma unroll
                    for (int m = 0; m < 4; ++m) { const int r = ai * 128 + wr * 64 + m * 16 + fr; bf16_t* rp = base + (size_t)r * rowlen + wc * 32 + 4 * fq;
#pragma unroll
                        for (int bj = 0; bj < 2; ++bj)
#pragma unroll
                            for (int n = 0; n < 2; ++n) *(u32x2*)(rp + bj * 128 + n * 16) = pack4(acc[ai][bj][m][n]); }
            }
        } else {
            const bool dorope = (pn < 8) && (pm < 128); const float sc = (pn == 4 || pn == 5 || pn == 8 || pn == 9) ? 0.125f : 1.0f;
            const int colbase = (pn - 4) * 256 + wc * 32 + 8 * fq; const int axis = wc & 1;
#pragma unroll
            for (int ai = 0; ai < 2; ++ai)
#pragma unroll
                for (int m = 0; m < 4; ++m) { const int r = ai * 128 + wr * 64 + m * 16 + fr; const int tok = pm * 256 + r; const int t = tok & 2047;
                    const int pos = axis ? (t & 63) : (t >> 6);
                    f32x4 cs = (f32x4){1.f, 1.f, 1.f, 1.f}, sn = (f32x4){0.f, 0.f, 0.f, 0.f};
                    if (dorope) { cs = *(const LAS f32x4*)(ropel + (pos * 16 + 4 * fq) * 4); sn = *(const LAS f32x4*)(ropel + 4096 + (pos * 16 + 4 * fq) * 4); }
                    bf16_t* rp = proj + (size_t)tok * 2048 + colbase;
#pragma unroll
                    for (int bj = 0; bj < 2; ++bj) { const f32x4 a = acc[ai][bj][m][0], bb = acc[ai][bj][m][1];
                        const f32x4 o0 = (a * cs - bb * sn) * sc, o1 = (a * sn + bb * cs) * sc;
                        const u32x2 p0 = pack4(o0), p1 = pack4(o1); u32x4 w; w.x = p0.x; w.y = p0.y; w.z = p1.x; w.w = p1.y; *(u32x4*)(rp + bj * 128) = w; } }
        }
    }
};

struct PolDft {
    const char* dmat; const char* dc; const char* T; const char* Tc; bf16_t* br; int G, c, nU;
    __device__ __forceinline__ bool unit(int i, UnitD& u) const {
        const long L = (long)i * G + c; if (L >= nU) return false;
        if (L < 256) { const int b = (int)L >> 4, pm = ((int)L >> 1) & 7, pn = (int)L & 1;
            u.A = dmat + (size_t)pm * 256 * 8192; u.lda = 8192; u.B = T + ((size_t)(b * 512 + pn * 256) * 4096) * 2; u.ldb = 8192; u.nt = 64; u.pm = b * 8 + pm; u.pn = pn; u.kind = 0; }
        else { const int b = ((int)L - 256) >> 1, pn = (int)L & 1;
            u.A = dc; u.lda = 1024; u.B = Tc + ((size_t)(b * 512 + pn * 256) * 512) * 2; u.ldb = 1024; u.nt = 8; u.pm = 128 + b; u.pn = pn; u.kind = 1; }
        u.br = 0; return true;
    }
    __device__ __forceinline__ void epi(Acc& acc, const UnitD& u, int wr, int wc, int fr, int fq, int tid) const {
        const float sc = u.kind ? 0.0055242717280199f : 0.001953125f;
#pragma unroll
        for (int ai = 0; ai < 2; ++ai)
#pragma unroll
            for (int m = 0; m < 4; ++m) { const int r = ai * 128 + wr * 64 + m * 16 + fr; bf16_t* rp = br + (size_t)(u.pm * 256 + r) * 1536 + u.pn * 256 + wc * 32 + 4 * fq;
#pragma unroll
                for (int bj = 0; bj < 2; ++bj)
#pragma unroll
                    for (int n = 0; n < 2; ++n) *(u32x2*)(rp + bj * 128 + n * 16) = pack4(acc[ai][bj][m][n] * sc); }
    }
};

struct PolMerge {
    const char* abuf; const char* brb; const char* wm; const float* bgate; u32x4* gscr; f32x4* sscr; bf16_t* merged; int G, c, nM;
    __device__ __forceinline__ bool unit(int i, UnitD& u) const {
        const int ti = i / 6, s = i - ti * 6; int pm, pn; if (!tile_order((long)ti * G + c, nM, 4, pm, pn)) return false;
        const int br = s >> 1; u.pm = pm; u.pn = pn; u.br = br; u.kind = s & 1; u.ldb = 3072;
        if (!(s & 1)) { u.A = abuf + (size_t)pm * 256 * 2048; u.lda = 2048; u.B = wm + ((size_t)(br * 1024 + pn * 256) * 1536) * 2; u.nt = 16; }
        else { u.A = brb + ((size_t)pm * 256 * 1536 + br * 512) * 2; u.lda = 3072; u.B = wm + ((size_t)(br * 1024 + pn * 256) * 1536 + 1024) * 2; u.nt = 8; }
        return true;
    }
    __device__ __forceinline__ void epi(Acc& acc, const UnitD& u, int wr, int wc, int fr, int fq, int tid) const {
        u32x4* gs = gscr + (size_t)blockIdx.x * 16 * 512 + tid; u32x4* ss = (u32x4*)sscr + (size_t)blockIdx.x * 16 * 512 + tid;
        if (u.kind == 0) {
            const float* bp = bgate + u.br * 1024 + u.pn * 256 + wc * 32 + 4 * fq;
#pragma unroll
            for (int bj = 0; bj < 2; ++bj) { const f32x4 b0 = *(const f32x4*)(bp + bj * 128), b1 = *(const f32x4*)(bp + bj * 128 + 16);
#pragma unroll
                for (int ai = 0; ai < 2; ++ai)
#pragma unroll
                    for (int m = 0; m < 4; ++m) { f32x4 v0 = acc[ai][bj][m][0] + b0, v1 = acc[ai][bj][m][1] + b1;
#pragma unroll
                        for (int j = 0; j < 4; ++j) { v0[j] = __builtin_amdgcn_rcpf(1.0f + __expf(-v0[j])); v1[j] = __builtin_amdgcn_rcpf(1.0f + __expf(-v1[j])); }
                        const u32x2 p0 = pack4(v0), p1 = pack4(v1); u32x4 w; w.x = p0.x; w.y = p0.y; w.z = p1.x; w.w = p1.y;
                        gs[((ai * 2 + bj) * 4 + m) * 512] = w; asm volatile("" ::: "memory"); } }
        } else {
            u32x4* sb = (u32x4*)ss;
            const f32x4 z4 = (f32x4){0.f, 0.f, 0.f, 0.f}; const bool addS = u.br > 0;
#pragma unroll
            for (int ai = 0; ai < 2; ++ai) {
                u32x4 gw[4][2], sw[4][2];
#pragma unroll
                for (int m = 0; m < 4; ++m)
#pragma unroll
                    for (int bj = 0; bj < 2; ++bj) { const int gi = ((ai * 2 + bj) * 4 + m); gw[m][bj] = gs[gi * 512]; sw[m][bj] = sb[gi * 512]; }
                asm volatile("" ::: "memory");
#pragma unroll
                for (int m = 0; m < 4; ++m) { const int r = ai * 128 + wr * 64 + m * 16 + fr; bf16_t* rp = merged + (size_t)(u.pm * 256 + r) * 1024 + u.pn * 256 + wc * 32 + 4 * fq;
#pragma unroll
                    for (int bj = 0; bj < 2; ++bj) { const int gi = ((ai * 2 + bj) * 4 + m); const u32x4 w = gw[m][bj], q = sw[m][bj];
                        u32x2 p0; p0.x = w.x; p0.y = w.y; u32x2 p1; p1.x = w.z; p1.y = w.w; u32x2 q0; q0.x = q.x; q0.y = q.y; u32x2 q1; q1.x = q.z; q1.y = q.w;
                        const f32x4 v0 = unpack4(p0) * acc[ai][bj][m][0] + sel4(addS, unpack4(q0), z4), v1 = unpack4(p1) * acc[ai][bj][m][1] + sel4(addS, unpack4(q1), z4);
                        const u32x2 o0 = pack4(v0), o1 = pack4(v1);
                        if (u.br < 2) { u32x4 o; o.x = o0.x; o.y = o0.y; o.z = o1.x; o.w = o1.y; sb[gi * 512] = o; }
                        else { *(u32x2*)(rp + bj * 128) = o0; *(u32x2*)(rp + bj * 128 + 16) = o1; } } }
                asm volatile("" ::: "memory");
            }
        }
    }
};

struct PolResid {
    const char* A; int lda; const char* wt; int ldb; int nt; const float* hx_in; float* hx_out; const float* hc_in; float* hc_out; const float* modl; int gidx; int G, c, nM;
    __device__ __forceinline__ bool unit(int i, UnitD& u) const {
        int pm, pn; if (!tile_order((long)i * G + c, nM, 4, pm, pn)) return false;
        u.pm = pm; u.pn = pn; u.kind = 0; u.br = 0; u.lda = lda; u.ldb = ldb; u.nt = nt;
        u.A = A + (size_t)pm * 256 * lda; u.B = wt + (size_t)pn * 256 * ldb; return true;
    }
    __device__ __forceinline__ void epi(Acc& acc, const UnitD& u, int wr, int wc, int fr, int fq, int tid) const {
        const bool lat = u.pm < 128; const int brow = lat ? (u.pm >> 3) : 16;
        const float* hin = lat ? hx_in + (size_t)u.pm * 256 * 1024 : hc_in + (size_t)(u.pm - 128) * 256 * 1024;
        float* hout = lat ? hx_out + (size_t)u.pm * 256 * 1024 : hc_out + (size_t)(u.pm - 128) * 256 * 1024;
        const int col0 = u.pn * 256 + wc * 32 + 4 * fq;
        const float* gp = modl + (size_t)brow * 6144 + gidx * 1024 + col0;
#pragma unroll
        for (int bj = 0; bj < 2; ++bj)
#pragma unroll
            for (int n = 0; n < 2; ++n) { const f32x4 g = *(const f32x4*)(gp + bj * 128 + n * 16);
#pragma unroll
                for (int ai = 0; ai < 2; ++ai)
#pragma unroll
                    for (int m = 0; m < 4; ++m) { const int r = ai * 128 + wr * 64 + m * 16 + fr; const unsigned off = (unsigned)(r * 1024 + col0 + bj * 128 + n * 16) * 4u;
                        acc[ai][bj][m][n] = ldg4(hin, off) + g * acc[ai][bj][m][n]; } }
        asm volatile("" ::: "memory");
#pragma unroll
        for (int ai = 0; ai < 2; ++ai)
#pragma unroll
            for (int m = 0; m < 4; ++m)
#pragma unroll
                for (int bj = 0; bj < 2; ++bj)
#pragma unroll
                    for (int n = 0; n < 2; ++n) { const int r = ai * 128 + wr * 64 + m * 16 + fr; const unsigned off = (unsigned)(r * 1024 + col0 + bj * 128 + n * 16) * 4u;
                        *(f32x4*)((char*)hout + (size_t)off) = acc[ai][bj][m][n]; }
    }
};

__device__ __forceinline__ f32x4 rot4(f32x4 v, int src) { f32x4 r; r[0] = bperm(v[0], src); r[1] = bperm(v[1], src); r[2] = bperm(v[2], src); r[3] = bperm(v[3], src); return r; }
struct PolUp {
    const char* abuf; const char* wt; const float* cw; const float* cb; bf16_t* gated; bf16_t* hb; int G, c, nM; LAS unsigned char* ldsx;
    __device__ __forceinline__ bool unit(int i, UnitD& u) const {
        int pm, pn; if (!tile_order((long)i * G + c, nM, 22, pm, pn)) return false;
        u.pm = pm; u.pn = pn; u.kind = 0; u.br = 0; u.lda = 2048; u.ldb = 2048; u.nt = 16;
        u.A = abuf + (size_t)pm * 256 * 2048; u.B = wt + (size_t)pn * 256 * 2048; return true;
    }
    __device__ __forceinline__ void epi(Acc& acc, const UnitD& u, int wr, int wc, int fr, int fq, int tid) const {
        const int lane = tid & 63; const int srcR = (lane & 48) | ((fr + 15) & 15), srcL = (lane & 48) | ((fr + 1) & 15);
        LAS unsigned char* wl = ldsx + (wr * 4 + wc) * 1024;
        { const int arr = lane & 3, fqv = (lane >> 2) & 3, hfv = (lane >> 4) & 1, nv = (lane >> 5) & 1;
          const int cidx = hfv * DFF + u.pn * 128 + wc * 32 + 8 * fqv + 4 * nv;
          const f32x4 v = (arr < 3) ? ldg4(cw, (unsigned)(arr * 2 * DFF + cidx) * 4u) : ldg4(cb, (unsigned)cidx * 4u);
          *(LAS f32x4*)(wl + lane * 16) = v; asm volatile("s_waitcnt lgkmcnt(0)" ::: "memory"); }
        const int jc = u.pn * 128 + wc * 32 + 8 * fq;
#pragma unroll
        for (int ai = 0; ai < 2; ++ai) {
            const int seg = u.pm * 4 + ai * 2 + wr;
            u32x2 pk[2][4];
#pragma unroll
            for (int n = 0; n < 2; ++n) {
                asm volatile("" : "+v"(acc[ai][0][0][n]), "+v"(acc[ai][0][1][n]), "+v"(acc[ai][0][2][n]), "+v"(acc[ai][0][3][n]), "+v"(acc[ai][1][0][n]), "+v"(acc[ai][1][1][n]), "+v"(acc[ai][1][2][n]), "+v"(acc[ai][1][3][n]) :: "memory");
                f32x4 uv[2][4];
#pragma unroll
                for (int hf = 1; hf >= 0; --hf) {
                    const LAS f32x4* wv = (const LAS f32x4*)(wl + ((n * 2 + hf) * 4 + fq) * 64);
                    const f32x4 w0 = wv[0], w1 = wv[1], w2 = wv[2], bb = wv[3];
                    f32x4 rrp = rot4(acc[ai][hf][0][n], srcR), rlc = rot4(acc[ai][hf][0][n], srcL);
#pragma unroll
                    for (int m = 0; m < 4; ++m) {
                        const f32x4 rrc = (m == 0) ? rrp : rot4(acc[ai][hf][m][n], srcR);
                        const f32x4 rln = (m < 3) ? rot4(acc[ai][hf][m + 1][n], srcL) : rlc;
                        const f32x4 prev = sel4(fr > 0, rrc, rrp);
                        const f32x4 next = sel4(fr < 15, rlc, rln);
                        uv[hf][m] = w0 * prev + w1 * acc[ai][hf][m][n] + w2 * next + bb;
                        rrp = rrc; rlc = rln;
                    }
                    __builtin_amdgcn_sched_barrier(0);
                }
#pragma unroll
                for (int m = 0; m < 4; ++m) { f32x4 g;
#pragma unroll
                    for (int j = 0; j < 4; ++j) { const float a = uv[0][m][j]; g[j] = a * __builtin_amdgcn_rcpf(1.0f + __expf(-a)) * uv[1][m][j]; }
                    pk[n][m] = pack4(g); }
            }
#pragma unroll
            for (int m = 0; m < 4; ++m) {
                const int r = ai * 128 + wr * 64 + m * 16 + fr;
                const bool bnd = (m == 0 && fr == 0) || (m == 3 && fr == 15);
                if (!bnd) { u32x4 o; o.x = pk[0][m].x; o.y = pk[0][m].y; o.z = pk[1][m].x; o.w = pk[1][m].y;
                    *(u32x4*)((char*)gated + (size_t)(((unsigned)(u.pm * 256 + r) * (unsigned)DFF + (unsigned)jc) * 2u)) = o; }
                if ((m == 0 && fr < 2) || (m == 3 && fr >= 14)) { const int slot = (m == 0) ? fr : fr - 12;
#pragma unroll
                    for (int hf = 0; hf < 2; ++hf) { const u32x2 a0 = pack4(acc[ai][hf][m][0]), a1 = pack4(acc[ai][hf][m][1]); u32x4 o; o.x = a0.x; o.y = a0.y; o.z = a1.x; o.w = a1.y;
                        *(u32x4*)((char*)hb + (size_t)(((unsigned)(seg * 4 + slot) * (unsigned)(2 * DFF) + (unsigned)(hf * DFF + jc)) * 2u)) = o; } }
            }
            asm volatile("" ::: "memory"); __builtin_amdgcn_sched_barrier(0);
        }
    }
};

#define SHX(v, mask) bperm((v), lane ^ (mask))
__device__ __forceinline__ float wave_sum(float v, int lane) { v += SHX(v, 32); v += SHX(v, 16); v += SHX(v, 8); v += SHX(v, 4); v += SHX(v, 2); v += SHX(v, 1); return v; }

__device__ __forceinline__ void conv_win_fold(const Params& p, unsigned char* ws, int l, float* tl, int wgi, int nwg, int kwid) {
    const float* src = p.w_in + (size_t)l * D * PROJW; bf16_t* dst = (bf16_t*)(ws + WS_WB);
    float* wsm = tl; float* tw = tl + 64 * 129;
    const int tid = lv(TIDX);
    if (wgi < 0) return;
    for (int it = wgi; it < 256; it += nwg) { const int g = it >> 6, k0 = ((it >> 2) & 15) * 64, cqb = (it & 3) * 32;
        if (tid < 128) { float s, c; sincospif((float)tid / 64.0f, &s, &c); tw[tid] = c; tw[128 + tid] = s; }
        for (int e = tid; e < 64 * 128; e += NTHR) { const int kk = e >> 7, cc = e & 127; wsm[kk * 129 + cc] = src[(size_t)(k0 + kk) * PROJW + g * 128 + cc]; }
        __syncthreads();
        const int kk = tid & 63, cq0 = tid >> 6;
        for (int i = 0; i < 4; ++i) { const int cp = cqb + cq0 + 8 * i; float ac = 0.f, as = 0.f;
            for (int cc = 0; cc < 128; ++cc) { const float w = wsm[kk * 129 + cc]; const int ix = (cc * cp) & 127; ac += w * tw[ix]; as += w * tw[128 + ix]; }
            dst[(size_t)(g * 128 + cp) * 1024 + k0 + kk] = (bf16_t)(cvt_pk_bf16(ac, 0.f) & 0xffff);
            dst[(size_t)(512 + g * 128 + cp) * 1024 + k0 + kk] = (bf16_t)(cvt_pk_bf16(as, 0.f) & 0xffff); }
        __syncthreads(); }
}
struct ConvD { const float* src; int sld, k0, scol0; bf16_t* dst; int dld, drow0, dk0, rperm; };
__device__ __forceinline__ ConvD conv_desc(const Params& p, unsigned char* ws, int l, int kind, int it) {
    ConvD d; d.rperm = 0; bf16_t* wb = (bf16_t*)(ws + WS_WB);
    if (kind == 0) { const int rt = it >> 4, kt = it & 15; const int blk = rt >> 3, within = (rt & 7) * 64;
        const int sc0 = (blk == 0 ? 512 : blk == 1 ? 1024 : blk == 2 ? 2048 : blk == 3 ? 2560 : blk == 4 ? 1536 : 3072) + within;
        d.src = p.w_in + (size_t)l * D * PROJW; d.sld = PROJW; d.k0 = kt * 64; d.scol0 = sc0; d.dst = wb; d.dld = 1024; d.drow0 = 1024 + rt * 64; d.dk0 = kt * 64; }
    else if (kind == 1) {
        if (it < 1152) { const int rt = it / 24, kt = it % 24; const int br = rt >> 4, n0 = (rt & 15) * 64; d.dst = wb; d.dld = 1536; d.drow0 = br * 1024 + n0;
            if (kt < 16) { d.src = p.w_in + (size_t)l * D * PROJW; d.sld = PROJW; d.k0 = kt * 64; d.scol0 = 3584 + br * 1024 + n0; d.dk0 = kt * 64; }
            else { d.src = (br == 0 ? p.w_a : br == 1 ? p.w_b : p.w_c) + (size_t)l * 512 * 1024; d.sld = 1024; d.k0 = (kt - 16) * 64; d.scol0 = n0; d.dk0 = 1024 + (kt - 16) * 64; } }
        else { const int j = it - 1152; const int rt = j >> 4, kt = j & 15; d.src = p.w_out + (size_t)l * 1024 * 1024; d.sld = 1024; d.k0 = kt * 64; d.scol0 = rt * 64; d.dst = (bf16_t*)(ws + WS_WB + 9437184); d.dld = 1024; d.drow0 = rt * 64; d.dk0 = kt * 64; } }
    else if (kind == 2) { const int rt = it >> 4, kt = it & 15; const int drow0 = rt * 64; const int pn = drow0 >> 8, bj = (drow0 >> 7) & 1, i0 = drow0 & 127;
        d.src = p.w_up + (size_t)l * 1024 * 5632; d.sld = 5632; d.k0 = kt * 64; d.scol0 = bj * DFF + pn * 128 + i0; d.rperm = 1; d.dst = (bf16_t*)(ws + WS_BIG + BIG_WUP); d.dld = 1024; d.drow0 = drow0; d.dk0 = kt * 64; }
    else { const int rt = it / 44, kt = it % 44; d.src = p.w_down + (size_t)l * DFF * 1024; d.sld = 1024; d.k0 = kt * 64; d.scol0 = rt * 64; d.dst = (bf16_t*)(ws + WS_BIG + BIG_WDOWN); d.dld = DFF; d.drow0 = rt * 64; d.dk0 = kt * 64; }
    return d;
}
__device__ __forceinline__ void conv_run(const Params& p, unsigned char* ws, int l, int kind, int ntiles, float* tl, int wgi, int nwg, int kwid) {
    const int tid = lv(TIDX);
    if (wgi < 0) return;
    for (int base = wgi * 4; base < ntiles; base += nwg * 4) {
#pragma unroll
        for (int q = 0; q < 4; ++q) { if (base + q < ntiles) { const ConvD d = conv_desc(p, ws, l, kind, base + q); float* t = tl + q * (64 * 65);
#pragma unroll
            for (int i = 0; i < 2; ++i) { const int kk = (tid >> 4) + 32 * i, c4 = (tid & 15) * 4;
                const f32x4 v = *(const f32x4*)(d.src + (size_t)(d.k0 + kk) * d.sld + d.scol0 + c4);
                t[kk * 65 + c4] = v[0]; t[kk * 65 + c4 + 1] = v[1]; t[kk * 65 + c4 + 2] = v[2]; t[kk * 65 + c4 + 3] = v[3]; } } }
        __syncthreads();
#pragma unroll
        for (int q = 0; q < 4; ++q) { if (base + q < ntiles) { const ConvD d = conv_desc(p, ws, l, kind, base + q); const float* t = tl + q * (64 * 65);
            const int r = tid >> 3, k8 = (tid & 7) * 8; float f[8];
            const int rho = r & 31; const int rs = d.rperm ? ((r & ~31) + 8 * ((rho & 15) >> 2) + 4 * (rho >> 4) + (rho & 3)) : r;
#pragma unroll
            for (int j = 0; j < 8; ++j) f[j] = t[(k8 + j) * 65 + rs];
            u32x4 w; w.x = cvt_pk_bf16(f[0], f[1]); w.y = cvt_pk_bf16(f[2], f[3]); w.z = cvt_pk_bf16(f[4], f[5]); w.w = cvt_pk_bf16(f[6], f[7]);
            *(u32x4*)(d.dst + (size_t)(d.drow0 + r) * d.dld + d.dk0 + k8) = w; } }
        __syncthreads();
    }
}
__device__ __forceinline__ void norm_phase(const float* hx, const float* hc, const float* g, const float* modl, int ish, int isc, bf16_t* abuf, int G, int nrows, int kwid) {
    const int tid_ = lv(TIDX); const int wave = tid_ >> 6, lane = tid_ & 63;
    for (int rowb = blockIdx.x * 8 + wave; rowb < nrows; rowb += G * 32) {
        f32x4 v[4][4]; int rows[4];
#pragma unroll
        for (int q = 0; q < 4; ++q) { const int r = rowb + q * G * 8; rows[q] = r; const int rc = r < nrows ? r : rowb;
            const float* src = (rc < MLAT) ? hx + (size_t)rc * 1024 : hc + (size_t)(rc - MLAT) * 1024;
#pragma unroll
            for (int i = 0; i < 4; ++i) v[q][i] = *(const f32x4*)(src + lane * 4 + 256 * i); }
#pragma unroll
        for (int q = 0; q < 4; ++q) { const int row = rows[q]; if (row < nrows) {
            const int brow = (row < MLAT) ? (row >> 11) : 16; const float* mp = modl + (size_t)brow * 6144;
            float ss = 0.f;
#pragma unroll
            for (int i = 0; i < 4; ++i) ss += v[q][i][0] * v[q][i][0] + v[q][i][1] * v[q][i][1] + v[q][i][2] * v[q][i][2] + v[q][i][3] * v[q][i][3];
            ss = wave_sum(ss, lane); const float rstd = rsqrtf(ss * (1.0f / 1024.0f) + 1e-6f);
#pragma unroll
            for (int i = 0; i < 4; ++i) { const int k = lane * 4 + 256 * i; const f32x4 gg = *(const f32x4*)(g + k), sh = *(const f32x4*)(mp + ish * 1024 + k), sc = *(const f32x4*)(mp + isc * 1024 + k);
                const f32x4 o = (v[q][i] * rstd * gg) * (sc + 1.0f) + sh; *(u32x2*)(abuf + (size_t)row * 1024 + k) = pack4(o); } } }
    }
}
__device__ __forceinline__ void final_norm(float* out, const float* g, int G, int kwid) {
    const int tid_ = lv(TIDX); const int wave = tid_ >> 6, lane = tid_ & 63;
    for (int rowb = blockIdx.x * 8 + wave; rowb < MLAT; rowb += G * 32) {
        f32x4 v[4][4];
#pragma unroll
        for (int q = 0; q < 4; ++q) { const int r = rowb + q * G * 8; const int rc = r < MLAT ? r : rowb;
#pragma unroll
            for (int i = 0; i < 4; ++i) v[q][i] = *(const f32x4*)(out + (size_t)rc * 1024 + lane * 4 + 256 * i); }
#pragma unroll
        for (int q = 0; q < 4; ++q) { const int row = rowb + q * G * 8; if (row < MLAT) { float ss = 0.f;
#pragma unroll
            for (int i = 0; i < 4; ++i) ss += v[q][i][0] * v[q][i][0] + v[q][i][1] * v[q][i][1] + v[q][i][2] * v[q][i][2] + v[q][i][3] * v[q][i][3];
            ss = wave_sum(ss, lane); const float rstd = rsqrtf(ss * (1.0f / 1024.0f) + 1e-6f);
#pragma unroll
            for (int i = 0; i < 4; ++i) { const int k = lane * 4 + 256 * i; const f32x4 gg = *(const f32x4*)(g + k); *(f32x4*)(out + (size_t)row * 1024 + k) = v[q][i] * rstd * gg; } } }
    }
}

__device__ __forceinline__ void fixup_phase(const bf16_t* hb, const float* cw, const float* cb, bf16_t* gated, int G, int nseg_all, int kwid) {
    const int total = nseg_all * 2 * (DFF / 4);
    for (int e = blockIdx.x * NTHR + lv(TIDX); e < total; e += G * NTHR) {
        const int j4 = (e % (DFF / 4)) * 4; const int sr = e / (DFF / 4); const int seg = sr >> 1, which = sr & 1;
        const bool lat = seg < 512; const int sl = lat ? (seg & 31) : ((seg - 512) & 3); const int nseg = lat ? 32 : 4;
        const bf16_t* pprev; const bf16_t* pcur; const bf16_t* pnext; bool zp = false, zn = false; int row;
        if (which == 0) { row = seg * 64; pcur = hb + (size_t)(seg * 4 + 0) * (2 * DFF); pnext = hb + (size_t)(seg * 4 + 1) * (2 * DFF); zp = (sl == 0); pprev = zp ? pcur : hb + (size_t)((seg - 1) * 4 + 3) * (2 * DFF); }
        else { row = seg * 64 + 63; pcur = hb + (size_t)(seg * 4 + 3) * (2 * DFF); pprev = hb + (size_t)(seg * 4 + 2) * (2 * DFF); zn = (sl == nseg - 1); pnext = zn ? pcur : hb + (size_t)((seg + 1) * 4 + 0) * (2 * DFF); }
        f32x4 uu[2];
#pragma unroll
        for (int hf = 0; hf < 2; ++hf) { const int cidx = hf * DFF + j4;
            f32x4 pv = unpack4(*(const u32x2*)(pprev + cidx)), cv = unpack4(*(const u32x2*)(pcur + cidx)), nv = unpack4(*(const u32x2*)(pnext + cidx));
            if (zp) pv = (f32x4){0.f, 0.f, 0.f, 0.f}; if (zn) nv = (f32x4){0.f, 0.f, 0.f, 0.f};
            uu[hf] = *(const f32x4*)(cw + cidx) * pv + *(const f32x4*)(cw + 2 * DFF + cidx) * cv + *(const f32x4*)(cw + 4 * DFF + cidx) * nv + *(const f32x4*)(cb + cidx); }
        f32x4 gg;
#pragma unroll
        for (int j = 0; j < 4; ++j) { const float a = uu[0][j]; gg[j] = a * __builtin_amdgcn_rcpf(1.0f + __expf(-a)) * uu[1][j]; }
        *(u32x2*)(gated + (size_t)row * DFF + j4) = pack4(gg);
    }
}

__device__ __forceinline__ void prep_a(const Params& p, unsigned char* ws, float* tl, int G, int kwid) {
    const int tid = lv(TIDX);
    float* modpart = (float*)(ws + WS_BIG + BIG_MODPART);
    for (int it = blockIdx.x; it < 4 * 24 * 8; it += G) { const int kc = it & 7, nc = (it >> 3) % 24, l = it / 192;
        __syncthreads();
        for (int e = tid; e < 17 * 128; e += NTHR) { const int r = e >> 7, k = e & 127; const float v = (r < 16) ? p.c[r * 1024 + kc * 128 + k] : p.c_ctx[kc * 128 + k]; tl[e] = v / (1.0f + __expf(-v)); }
        __syncthreads();
        const int col = nc * 256 + (tid & 255), kh = tid >> 8; float acc[17];
#pragma unroll
        for (int r = 0; r < 17; ++r) acc[r] = 0.f;
        const float* wp = p.w_ada + (size_t)l * 1024 * 6144 + (size_t)(kc * 128 + kh * 64) * 6144 + col;
        for (int k = 0; k < 64; ++k) { const float w = wp[(size_t)k * 6144];
#pragma unroll
            for (int r = 0; r < 17; ++r) acc[r] += tl[r * 128 + kh * 64 + k] * w; }
        float* xs = tl + 17 * 128;
        if (kh == 1) {
#pragma unroll
            for (int r = 0; r < 17; ++r) xs[r * 256 + (tid & 255)] = acc[r]; }
        __syncthreads();
        if (kh == 0) {
#pragma unroll
            for (int r = 0; r < 17; ++r) modpart[((size_t)(kc * 4 + l) * 17 + r) * 6144 + col] = acc[r] + xs[r * 256 + (tid & 255)]; }
    }
    { float* rope = (float*)(ws + WS_ROPE);
      for (int e = blockIdx.x * NTHR + tid; e < 1024; e += G * NTHR) { const int pos = e >> 4, f = e & 15; const float inv = powf(10000.0f, -(float)f / 16.0f); const float ang = (float)pos * inv; rope[e] = cosf(ang); rope[1024 + e] = sinf(ang); } }
    if (blockIdx.x == 0 && tid < 64) { float* lamv = (float*)(ws + WS_LAM);
        for (int l = 0; l < 4; ++l) { const float* lv = p.lam + l * 256; const int lane = tid & 63; const float s1 = wave_sum(lv[tid] * lv[64 + tid], lane), s2 = wave_sum(lv[128 + tid] * lv[192 + tid], lane);
            if (tid == 0) lamv[l] = expf(s1) - expf(s2) + (0.8f - 0.6f * expf(-0.3f * (float)l)); } }
    __syncthreads();
    for (int e = tid; e < 2048; e += NTHR) tl[e] = cospif((float)e / 1024.0f);
    __syncthreads();
    { bf16_t* dm = (bf16_t*)(ws + WS_DMAT);
      for (int e = blockIdx.x * NTHR + tid; e < 2048 * 512; e += G * NTHR) { const int n = e >> 9, k8 = (e & 511) * 8; float f[8];
#pragma unroll
          for (int j = 0; j < 8; ++j) { const int kp = k8 + j; const int k = (kp & ~31) | (((kp >> 2) & 1) << 4) | (((kp >> 3) & 3) << 2) | (kp & 3); f[j] = (k < 2048) ? tl[(n * k) & 2047] : -tl[(n * (k - 2048) + 1536) & 2047]; }
          u32x4 w; w.x = cvt_pk_bf16(f[0], f[1]); w.y = cvt_pk_bf16(f[2], f[3]); w.z = cvt_pk_bf16(f[4], f[5]); w.w = cvt_pk_bf16(f[6], f[7]);
          *(u32x4*)(dm + (size_t)n * 4096 + k8) = w; }
      bf16_t* dc = (bf16_t*)(ws + WS_DC);
      for (int e = blockIdx.x * NTHR + tid; e < 256 * 64; e += G * NTHR) { const int n = e >> 6, k8 = (e & 63) * 8; float f[8];
#pragma unroll
          for (int j = 0; j < 8; ++j) { const int kp = k8 + j; const int k = (kp & ~31) | (((kp >> 2) & 1) << 4) | (((kp >> 3) & 3) << 2) | (kp & 3); f[j] = (k < 256) ? tl[((n * k) & 255) * 8] : -tl[(((n * (k - 256)) & 255) * 8 + 1536) & 2047]; }
          u32x4 w; w.x = cvt_pk_bf16(f[0], f[1]); w.y = cvt_pk_bf16(f[2], f[3]); w.z = cvt_pk_bf16(f[4], f[5]); w.w = cvt_pk_bf16(f[6], f[7]);
          *(u32x4*)(dc + (size_t)n * 512 + k8) = w; } }
}
__device__ __forceinline__ void prep_b(const Params& p, unsigned char* ws, int G, int kwid) {
    const float* modpart = (const float*)(ws + WS_BIG + BIG_MODPART); float* mod = (float*)(ws + WS_MOD);
    for (int e = blockIdx.x * NTHR + lv(TIDX); e < 4 * 17 * 6144; e += G * NTHR) { const int n = e % 6144, l = e / (17 * 6144); float s = p.b_ada[l * 6144 + n];
#pragma unroll
        for (int kc = 0; kc < 8; ++kc) s += modpart[(size_t)kc * (4 * 17 * 6144) + e];
        mod[e] = s; }
}

#define MFMA16(a, b, c) __builtin_amdgcn_mfma_f32_16x16x32_bf16(a, b, c, 0, 0, 0)
constexpr float LOG2E = 1.4426950408889634f;
__device__ __forceinline__ bf16x8 mk8(u32x2 a, u32x2 b) { u32x4 w; w.x = a.x; w.y = a.y; w.z = b.x; w.w = b.y; return __builtin_bit_cast(bf16x8, w); }

__device__ __forceinline__ void diffattn_item(LAS unsigned char* lds, const bf16_t* proj, const bf16_t* vtb, bf16_t* brb, const float* subg, float lam, int post,
                              int b, int h, int qtok0, int kt0, int kt1, int kwid) {
    const int tid = lv(TIDX), wid = __builtin_amdgcn_readfirstlane(tid >> 6), lane = tid & 63, fr = lane & 15, fq = lane >> 4;
    const int sub = wid >> 2, qrow0 = qtok0 + (wid & 3) * 32;
    bf16x8 qf[2][2];
#pragma unroll
    for (int qt = 0; qt < 2; ++qt)
#pragma unroll
        for (int dh = 0; dh < 2; ++dh) qf[qt][dh] = *(const bf16x8*)(proj + (size_t)(qrow0 + qt * 16 + fr) * 2048 + h * 128 + sub * 64 + dh * 32 + fq * 8);
    f32x4 O[8][2];
#pragma unroll
    for (int et = 0; et < 8; ++et) { O[et][0] = (f32x4){0.f, 0.f, 0.f, 0.f}; O[et][1] = (f32x4){0.f, 0.f, 0.f, 0.f}; }
    float mrun[2] = {-1e30f, -1e30f}, lrun[2] = {0.f, 0.f};
    u32x4 kreg[4], vreg[4];
    const unsigned koff0 = (unsigned)((tid >> 4) * 2048 + (tid & 15) * 8) * 2u, voff0 = (unsigned)((tid >> 4) * 2304 + (tid & 15) * 8) * 2u;
#define DA_GLOAD(kt) do { const int _kr = (kt) < 16 ? b * 2048 + (kt) * 128 : MLAT + b * 256 + ((kt) - 16) * 128; \
        const char* _kb = (const char*)(proj + (size_t)_kr * 2048 + 512 + h * 128); const char* _vb = (const char*)(vtb + (size_t)(b * 512 + h * 128) * 2304 + (kt) * 128); \
        _Pragma("unroll") for (int _i = 0; _i < 4; ++_i) { \
        kreg[_i] = *(const u32x4*)(_kb + (size_t)_i * (32 * 2048 * 2) + (size_t)koff0); \
        vreg[_i] = *(const u32x4*)(_vb + (size_t)_i * (32 * 2304 * 2) + (size_t)voff0); } } while (0)
#define DA_LWRITE(kb) do { _Pragma("unroll") for (int _i = 0; _i < 4; ++_i) { const int ch = tid + 512 * _i; \
        *(LAS u32x4*)(lds + (kb) * 34816 + (ch >> 4) * 272 + (ch & 15) * 16) = kreg[_i]; \
        *(LAS u32x4*)(lds + 69632 + (kb) * 34816 + (ch >> 4) * 272 + (ch & 15) * 16) = vreg[_i]; } } while (0)
    __syncthreads();
    DA_GLOAD(kt0); DA_LWRITE(0); __syncthreads();
    for (int kt = kt0; kt < kt1; ++kt) {
        const int cur = (kt - kt0) & 1;
        if (kt + 1 < kt1) DA_GLOAD(kt + 1);
#pragma unroll
        for (int hk = 0; hk < 2; ++hk) {
        f32x4 S[4][2];
#pragma unroll
        for (int kq = 0; kq < 4; ++kq) { S[kq][0] = (f32x4){0.f, 0.f, 0.f, 0.f}; S[kq][1] = (f32x4){0.f, 0.f, 0.f, 0.f}; }
#pragma unroll
        for (int kq = 0; kq < 4; ++kq)
#pragma unroll
            for (int dh = 0; dh < 2; ++dh) { const bf16x8 kf = *(const LAS bf16x8*)(lds + cur * 34816 + (hk * 64 + kq * 16 + fr) * 272 + (sub * 64 + dh * 32 + fq * 8) * 2);
                S[kq][0] = MFMA16(kf, qf[0][dh], S[kq][0]); S[kq][1] = MFMA16(kf, qf[1][dh], S[kq][1]); }
        bf16x8 pb[2][2];
#pragma unroll
        for (int qt = 0; qt < 2; ++qt) {
            float mx = -1e30f;
#pragma unroll
            for (int kq = 0; kq < 4; ++kq)
#pragma unroll
                for (int j = 0; j < 4; ++j) mx = fmaxf(mx, S[kq][qt][j]);
            mx = fmaxf(mx, SHX(mx, 16)); mx = fmaxf(mx, SHX(mx, 32));
            const float mxs = mx * LOG2E; const float mnew = (mxs > mrun[qt] + 8.0f) ? mxs : mrun[qt]; const float alpha = __builtin_amdgcn_exp2f(mrun[qt] - mnew); mrun[qt] = mnew;
            f32x4 lsv = (f32x4){0.f, 0.f, 0.f, 0.f}; u32x2 pk[4];
#pragma unroll
            for (int kq = 0; kq < 4; ++kq) { const f32x4 t = S[kq][qt] * LOG2E - mnew; f32x4 pv;
#pragma unroll
                for (int j = 0; j < 4; ++j) pv[j] = __builtin_amdgcn_exp2f(t[j]);
                lsv += pv; pk[kq] = pack4(pv); }
            lrun[qt] = lrun[qt] * alpha + ((lsv[0] + lsv[1]) + (lsv[2] + lsv[3]));
            if (__builtin_amdgcn_ballot_w64(alpha != 1.0f) != 0ull) {
#pragma unroll
                for (int et = 0; et < 8; ++et) O[et][qt] *= alpha; }
            pb[qt][0] = mk8(pk[0], pk[1]); pb[qt][1] = mk8(pk[2], pk[3]);
        }
#pragma unroll
        for (int kc2 = 0; kc2 < 2; ++kc2)
#pragma unroll
            for (int et = 0; et < 8; ++et) { const bf16x8 vf = *(const LAS bf16x8*)(lds + 69632 + cur * 34816 + (et * 16 + fr) * 272 + (hk * 64 + kc2 * 32 + fq * 8) * 2);
                O[et][0] = MFMA16(vf, pb[0][kc2], O[et][0]); O[et][1] = MFMA16(vf, pb[1][kc2], O[et][1]); }
        }
        if (kt + 1 < kt1) DA_LWRITE(cur ^ 1);
        __syncthreads();
    }
#undef DA_GLOAD
#undef DA_LWRITE
#pragma unroll
    for (int qt = 0; qt < 2; ++qt) { float l = lrun[qt]; l += SHX(l, 16); l += SHX(l, 32); const float inv = 1.0f / l;
#pragma unroll
        for (int et = 0; et < 8; ++et) O[et][qt] *= inv; }
    if (sub == 1) {
#pragma unroll
        for (int qt = 0; qt < 2; ++qt)
#pragma unroll
            for (int et = 0; et < 8; ++et) *(LAS f32x4*)(lds + ((wid & 3) * 16 + qt * 8 + et) * 1024 + lane * 16) = O[et][qt]; }
    __syncthreads();
    if (sub == 0) {
#pragma unroll
        for (int qt = 0; qt < 2; ++qt) { float ss = 0.f;
#pragma unroll
            for (int et = 0; et < 8; ++et) { const f32x4 x1 = *(const LAS f32x4*)(lds + ((wid & 3) * 16 + qt * 8 + et) * 1024 + lane * 16); const f32x4 o = O[et][qt] - x1 * lam; O[et][qt] = o;
                ss += o[0] * o[0] + o[1] * o[1] + o[2] * o[2] + o[3] * o[3]; }
            ss += SHX(ss, 16); ss += SHX(ss, 32);
            const int li_ = post; const int pbits_ = lsg(li_ == 0 ? (int)0x3f4ccccdu : li_ == 1 ? (int)0x3f24fd5cu : li_ == 2 ? (int)0x3f077f5au : (int)0x3ee34c57u); const float postf = __int_as_float(pbits_);
            const float rstd = rsqrtf(ss * (1.0f / 128.0f) + 1e-5f) * postf;
            bf16_t* rp = brb + (size_t)(qrow0 + qt * 16 + fr) * 1536 + 512 + h * 128 + fq * 4;
#pragma unroll
            for (int et = 0; et < 8; ++et) { const f32x4 g = *(const f32x4*)(subg + et * 16 + fq * 4); *(u32x2*)(rp + et * 16) = pack4(O[et][qt] * rstd * g); } } }
    __syncthreads();
}

__device__ __forceinline__ void na_chunk(const LAS unsigned char* kb, const LAS unsigned char* vb, int vstride, int kbase, const bf16x8 (&qf)[2], f32x4 (&O)[4], float& mrun, float& lrun,
                                         int fr, int fq, bool usebias, const LAS float* rpbs, int rowidx0, const int (&dcoff)[8]) {
    const int lane = fq * 16 + fr;
    f32x4 S[4];
#pragma unroll
    for (int kq = 0; kq < 4; ++kq) { S[kq] = (f32x4){0.f, 0.f, 0.f, 0.f};
#pragma unroll
        for (int dh = 0; dh < 2; ++dh) { const bf16x8 kf = *(const LAS bf16x8*)(kb + (kbase + kq * 16 + fr) * 144 + (dh * 32 + fq * 8) * 2); S[kq] = MFMA16(kf, qf[dh], S[kq]); } }
    if (usebias) {
#pragma unroll
        for (int kq = 0; kq < 4; ++kq)
#pragma unroll
            for (int j = 0; j < 4; ++j) { const int dco = dcoff[(kq & 1) * 4 + j];
                const float bv = *(const LAS float*)((const LAS unsigned char*)rpbs + (rowidx0 + (kq >> 1)) * 124 + (dco < 0 ? 0 : dco)); S[kq][j] = dco >= 0 ? S[kq][j] + bv : -1e30f; } }
    float mx = -1e30f;
#pragma unroll
    for (int kq = 0; kq < 4; ++kq)
#pragma unroll
        for (int j = 0; j < 4; ++j) mx = fmaxf(mx, S[kq][j]);
    mx = fmaxf(mx, SHX(mx, 16)); mx = fmaxf(mx, SHX(mx, 32));
    const float mnew = fmaxf(mrun, mx * LOG2E); const float alpha = __builtin_amdgcn_exp2f(mrun - mnew); mrun = mnew;
    f32x4 lsv = (f32x4){0.f, 0.f, 0.f, 0.f}; u32x2 pk[4];
#pragma unroll
    for (int kq = 0; kq < 4; ++kq) { const f32x4 t = S[kq] * LOG2E - mnew; f32x4 pv;
#pragma unroll
        for (int j = 0; j < 4; ++j) pv[j] = __builtin_amdgcn_exp2f(t[j]);
        lsv += pv; pk[kq] = pack4(pv); }
    lrun = lrun * alpha + ((lsv[0] + lsv[1]) + (lsv[2] + lsv[3]));
    const bf16x8 pb0 = mk8(pk[0], pk[1]), pb1 = mk8(pk[2], pk[3]);
#pragma unroll
    for (int et = 0; et < 4; ++et) { O[et] *= alpha;
        const LAS unsigned char* vp = vb + (et * 16 + fr) * vstride + (kbase + fq * 4) * 2;
        O[et] = MFMA16(mk8(*(const LAS u32x2*)vp, *(const LAS u32x2*)(vp + 32)), pb0, O[et]);
        O[et] = MFMA16(mk8(*(const LAS u32x2*)(vp + 64), *(const LAS u32x2*)(vp + 96)), pb1, O[et]); }
}

__device__ __forceinline__ void na_item(LAS unsigned char* lds, const bf16_t* proj, const bf16_t* vtc, const float* rpbh, bf16_t* brb, int b, int h, int mode, int jblk, int band, int kwid) {
    const int tid = lv(TIDX), wid = __builtin_amdgcn_readfirstlane(tid >> 6), lane = tid & 63, fr = lane & 15, fq = lane >> 4;
    const int qtok = (mode == 0) ? b * 2048 + (band * 8 + wid) * 64 + jblk * 16 + fr : MLAT + b * 256 + band * 128 + wid * 16 + fr;
    bf16x8 qf[2];
#pragma unroll
    for (int dh = 0; dh < 2; ++dh) qf[dh] = *(const bf16x8*)(proj + (size_t)qtok * 2048 + 1024 + h * 64 + dh * 32 + fq * 8);
    f32x4 O[4];
#pragma unroll
    for (int et = 0; et < 4; ++et) O[et] = (f32x4){0.f, 0.f, 0.f, 0.f};
    float mrun = -1e30f, lrun = 0.f;
    LAS float* rpbs = (LAS float*)(lds + 133120);
    __syncthreads();
#pragma unroll
    for (int i = 0; i < 4; ++i) { const int ch = tid + 512 * i; const int key = ch >> 3, c16 = ch & 7;
        *(LAS u32x4*)(lds + key * 144 + c16 * 16) = *(const u32x4*)(proj + (size_t)(MLAT + b * 256 + key) * 2048 + 1536 + h * 64 + c16 * 8);
        const int e = ch >> 5, d16 = ch & 31;
        *(LAS u32x4*)(lds + 36864 + e * 528 + d16 * 16) = *(const u32x4*)(vtc + (size_t)(b * 512 + h * 64 + e) * 2304 + 2048 + d16 * 8); }
    if (mode == 0) for (int e = tid; e < 465; e += NTHR) rpbs[e] = rpbh[e];
    const int rfirst = band * 8; const int R0 = min(max(rfirst - 4, 0), 24), nrows = min(max(rfirst + 7 - 4, 0), 24) + 8 - R0; const int kc0 = min(max(16 * jblk - 8, 0), 32);
    const int per_e = nrows * 4;
    int dcoff[8];
    { const int qcol_ = jblk * 16 + fr; const int c0_ = min(max(qcol_ - 8, 0), 48);
#pragma unroll
      for (int t = 0; t < 8; ++t) { const int kcol = kc0 + (t >> 2) * 16 + fq * 4 + (t & 3); const bool ok = (kcol >= c0_) && (kcol < c0_ + 16); const int dc = min(max(kcol - qcol_ + 15, 0), 30); dcoff[t] = ok ? dc * 4 : -1; } }
    u32x4 kl[8], vl[8];
    if (mode == 0) {
#pragma unroll
        for (int i = 0; i < 8; ++i) { const int ch = tid + 512 * i;
            if (ch < nrows * 256) { const int key = ch >> 3, c16 = ch & 7; const int il = key >> 5, w = key & 31;
                kl[i] = *(const u32x4*)(proj + (size_t)(b * 2048 + (R0 + il) * 64 + kc0 + w) * 2048 + 1536 + h * 64 + c16 * 8); }
            if (ch < 64 * per_e) { const int e = ch / per_e, rem = ch - e * per_e; const int il = rem >> 2, c16 = rem & 3;
                vl[i] = *(const u32x4*)(vtc + (size_t)(b * 512 + h * 64 + e) * 2304 + (R0 + il) * 64 + kc0 + c16 * 8); } }
    }
    __syncthreads();
#pragma unroll 1
    for (int c = 0; c < 4; ++c) na_chunk(lds, lds + 36864, 528, c * 64, qf, O, mrun, lrun, fr, fq, false, rpbs, 0, dcoff);
    if (mode == 0) {
        __syncthreads();
#pragma unroll
        for (int i = 0; i < 8; ++i) { const int ch = tid + 512 * i;
            if (ch < nrows * 256) { const int key = ch >> 3, c16 = ch & 7; *(LAS u32x4*)(lds + key * 144 + c16 * 16) = kl[i]; }
            if (ch < 64 * per_e) { const int e = ch / per_e, rem = ch - e * per_e; const int il = rem >> 2, c16 = rem & 3; *(LAS u32x4*)(lds + 69120 + e * 976 + (il * 32 + c16 * 8) * 2) = vl[i]; } }
        __syncthreads();
        const int r = band * 8 + wid; const int r0 = min(max(r - 4, 0), 24); const int ilb = r0 - R0; const int qcol = jblk * 16 + fr;
#pragma unroll 1
        for (int c = 0; c < 4; ++c) na_chunk(lds, lds + 69120, 976, (ilb + 2 * c) * 32, qf, O, mrun, lrun, fr, fq, true, rpbs, r0 + 2 * c - r + 7, dcoff);
    }
    float l = lrun; l += SHX(l, 16); l += SHX(l, 32); const float inv = 1.0f / l;
    bf16_t* rp = brb + (size_t)qtok * 1536 + 1024 + h * 64 + fq * 4;
#pragma unroll
    for (int et = 0; et < 4; ++et) *(u32x2*)(rp + et * 16) = pack4(O[et] * inv);
    __syncthreads();
}


#define XB_TMO      128
#define XB_XCNT(j)  (256  + 64 * (j))
#define XB_XSUB(j)  (1280 + 64 * (j))
#define XB_XGEN(j)  (2304 + 64 * (j))
#define XB_TOP      3328
#define XB_TOPGEN   3392
#define XCD_BAR_WORDS 3456
#define XB_SPIN_CAP (1u << 22)
__device__ __forceinline__ unsigned xb_ld(unsigned* p)              { return __hip_atomic_load(p, __ATOMIC_RELAXED, __HIP_MEMORY_SCOPE_AGENT); }
__device__ __forceinline__ unsigned xb_add(unsigned* p, unsigned v) { return __hip_atomic_fetch_add(p, v, __ATOMIC_RELAXED, __HIP_MEMORY_SCOPE_AGENT); }
__device__ __forceinline__ unsigned xb_xcc_id() { return (unsigned)__builtin_amdgcn_s_getreg((3 << 11) | 20) & 0xFu; }
#define XB_SPIN(cond, bar) do { unsigned _sp = 0; while (cond) { __builtin_amdgcn_s_sleep(1); \
    if ((++_sp & 255u) == 0u) { if (xb_ld(&(bar)[XB_TMO])) break; if (_sp > XB_SPIN_CAP) { atomicAdd(&(bar)[XB_TMO], 1u); break; } } } } while (0)
__device__ __forceinline__ void xcd_barrier_complete(unsigned* bar, unsigned x, unsigned G, unsigned& nloc, unsigned& nx) {
    unsigned sum, cnt, mine, sp = 0u;
    for (;;) {
        sum = 0u; cnt = 0u; mine = 0u;
#pragma unroll
        for (unsigned j = 0; j < 16; ++j) { const unsigned c = xb_ld(&bar[XB_XCNT(j)]); sum += c; cnt += (c > 0u) ? 1u : 0u; mine = (j == x) ? c : mine; }
        if (sum == G) break;
        __builtin_amdgcn_s_sleep(1);
        if ((++sp & 255u) == 0u) { if (xb_ld(&bar[XB_TMO])) break; if (sp > XB_SPIN_CAP) { atomicAdd(&bar[XB_TMO], 1u); break; } }
    }
    nloc = mine > 0u ? mine : 1u; nx = cnt > 0u ? cnt : 1u;
}
__device__ __forceinline__ void xcd_barrier(unsigned* bar, volatile LAS unsigned* st, unsigned G, int kwid) {
    asm volatile("s_waitcnt vmcnt(0)" ::: "memory");
    __syncthreads();
    if (TIDX == 0) {
        __builtin_amdgcn_s_waitcnt(0);
        const unsigned x = xb_xcc_id();
        unsigned nloc = st[0], nx = st[1];
        if (nloc == 0u) { xcd_barrier_complete(bar, x, G, nloc, nx); st[0] = nloc; st[1] = nx; }
        const unsigned old = xb_add(&bar[XB_XSUB(x)], 1u);
        const unsigned gen = old / nloc;
        if (old + 1u == (gen + 1u) * nloc) {
            __builtin_amdgcn_fence(__ATOMIC_RELEASE, "agent");
            asm volatile("s_waitcnt vmcnt(0)" ::: "memory");
            const unsigned og = xb_add(&bar[XB_TOP], 1u);
            const unsigned tg = og / nx;
            if (og + 1u == (tg + 1u) * nx) xb_add(&bar[XB_TOPGEN], 1u);
            else XB_SPIN(xb_ld(&bar[XB_TOPGEN]) == tg, bar);
            __builtin_amdgcn_fence(__ATOMIC_ACQUIRE, "agent");
            xb_add(&bar[XB_XGEN(x)], 1u);
            asm volatile("s_waitcnt vmcnt(0)" ::: "memory");
        } else {
            XB_SPIN(xb_ld(&bar[XB_XGEN(x)]) == gen, bar);
            __builtin_amdgcn_fence(__ATOMIC_ACQUIRE, "agent");
            asm volatile("s_waitcnt vmcnt(0)" ::: "memory");
        }
    }
    __syncthreads();
}

#ifdef REPEAT_S
constexpr int NPHASE = 2 + 10 * DEPTH + 1;
#else
constexpr int NPHASE = 2 + 9 * DEPTH + 1;
#endif
#ifndef EN
#define EN 0xFFFF
#endif
#define ON(k) ((EN >> (k)) & 1)
__global__ void __launch_bounds__(NTHR) mega(Params p_in, int ph_lo, int ph_hi) {
    extern __shared__ __attribute__((aligned(16))) unsigned char smem[];
    LAS unsigned char* lds = (LAS unsigned char*)smem;
    float* tl = (float*)smem;
    const int kwid = __builtin_amdgcn_readfirstlane((int)threadIdx.x >> 6);
    cg::grid_group grid = cg::this_grid();
    volatile LAS unsigned* xst = (volatile LAS unsigned*)(lds + LDS_BYTES - 16);
    { unsigned* bar0 = (unsigned*)(p_in.ws + WS_BAR); if (TIDX == 0) { xst[0] = 0u; xst[1] = 0u; (void)xb_add(&bar0[XB_XCNT(xb_xcc_id())], 1u); } __syncthreads(); }
    for (int ph = ph_lo; ph < ph_hi; ++ph) {
        const int G = lsg((int)gridDim.x), c = lsg((int)blockIdx.x);
        const Params& p = p_in; unsigned char* ws = lptr(p_in.ws); float* outp = lptr(p_in.out);
        const float* mod = (const float*)(ws + WS_MOD);
        bf16_t* abuf = (bf16_t*)(ws + WS_ABUF); bf16_t* brb = (bf16_t*)(ws + WS_BR);
        float* hc = (float*)(ws + WS_HC);
        unsigned char* big = ws + WS_BIG;
        if (ph == 0) { if (ON(0)) prep_a(p, ws, tl, G, kwid); }
        else if (ph == 1) { if (ON(0)) prep_b(p, ws, G, kwid); }
        else if (ph == NPHASE - 1) final_norm(outp, p.g_final, G, kwid);
        else {
#ifdef REPEAT_S
            const int l = (ph - 2) / 10, s_ = (ph - 2) % 10; const int s = (s_ <= REPEAT_S) ? s_ : s_ - 1;
#define PROBE_NOSTORE ((s_ == REPEAT_S + 1) ? 1 : 0)
#else
            const int l = (ph - 2) / 9, s = (ph - 2) % 9;
#define PROBE_NOSTORE 0
#endif
            const float* modl = mod + (size_t)l * 17 * 6144;
            const bool lastl = (l == DEPTH - 1); const int nMl = lastl ? 128 : 144;
            const float* hx_in = (l == 0) ? p.x : outp; const float* hc_in = (l == 0) ? p.ctx : hc;
            const int swg = lastl ? c : c - 64, snw = lastl ? G : G - 64;
            if (s == 0) { if (l == 0) { conv_run(p, ws, l, 0, 768, tl, c, G, kwid); conv_win_fold(p, ws, l, tl, c, G, kwid); } norm_phase(hx_in, hc_in, p.g_mix + l * 1024, modl, 0, 1, abuf, G, MTOT, kwid); }
            else if (s == 1) { PolInProj pol{(const char*)abuf, (const char*)(ws + WS_WB), (bf16_t*)(big + BIG_PROJ), (bf16_t*)(big + BIG_T), (bf16_t*)(big + BIG_TC), (bf16_t*)(big + BIG_VTB), (bf16_t*)(big + BIG_VTC), lds + 131072, G, c, PROBE_NOSTORE};
                { const int t_ = lv(TIDX); const float* rope = (const float*)(ws + WS_ROPE); for (int e = t_; e < 2048; e += NTHR) *(LAS float*)(lds + 131072 + e * 4) = rope[e]; __syncthreads(); }
                gemm_run(lds, pol, kwid); }
            else if (s == 2) {
                conv_run(p, ws, l, 1, 1408, tl, c, G, kwid);
                { PolDft pol{(const char*)(ws + WS_DMAT), (const char*)(ws + WS_DC), (const char*)(big + BIG_T), (const char*)(big + BIG_TC), brb, G, c, lastl ? 256 : 288}; gemm_run(lds, pol, kwid); }
                const bf16_t* proj = (const bf16_t*)(big + BIG_PROJ);
                const float lam = __int_as_float(__builtin_amdgcn_readfirstlane(__float_as_int(((const float*)(ws + WS_LAM))[l]))); const int post = l;
                for (long L = c; L < (lastl ? 1024 : 1024 + 128); L += G) {
                    int b_, h_, q0_, k0_;
                    if (L < 1024) { const int rr = (int)L >> 8, cc = (int)L & 255; const int pair = rr * 16 + (cc & 7) * 2 + (cc >> 7), qb = (cc >> 3) & 15; b_ = pair >> 2; h_ = pair & 3; q0_ = b_ * 2048 + qb * 128; k0_ = 0; }
                    else { const int j = (int)L - 1024; b_ = j >> 3; h_ = (j >> 1) & 3; q0_ = MLAT + b_ * 256 + (j & 1) * 128; k0_ = 16; }
                    diffattn_item(lds, proj, (const bf16_t*)(big + BIG_VTB), brb, p.subln_g + l * 128, lam, post, b_, h_, q0_, k0_, 18, kwid); }
                for (long L = c; L < (lastl ? 2048 : 2048 + 256); L += G) {
                    int b_, h_, mode_, j_, band_;
                    if (L < 2048) { const int rr = (int)L >> 8, cc = (int)L & 255; const int pair = rr * 16 + (cc & 7) * 2 + (cc >> 7), sub = (cc >> 3) & 15; b_ = pair >> 3; h_ = pair & 7; mode_ = 0; j_ = sub & 3; band_ = sub >> 2; }
                    else { const int j = (int)L - 2048; b_ = j >> 4; h_ = (j >> 1) & 7; mode_ = 1; j_ = 0; band_ = j & 1; }
                    na_item(lds, proj, (const bf16_t*)(big + BIG_VTC), p.rpb + (size_t)(l * 8 + h_) * 465, brb, b_, h_, mode_, j_, band_, kwid); }
            }
            else if (s == 3) { PolMerge pol{(const char*)abuf, (const char*)brb, (const char*)(ws + WS_WB), p.b_gate + l * 3072, (u32x4*)(big + BIG_GSCR), (f32x4*)(big + BIG_SSCR), (bf16_t*)(big + BIG_MERGED), G, c, nMl}; gemm_run(lds, pol, kwid);
                conv_run(p, ws, l, 2, 1408, tl, swg, snw, kwid); conv_run(p, ws, l, 3, 704, tl, swg, snw, kwid); }
            else if (s == 4) { PolResid pol{(const char*)(big + BIG_MERGED), 2048, (const char*)(ws + WS_WB + 9437184), 2048, 16, hx_in, outp, hc_in, hc, modl, 2, G, c, nMl}; gemm_run(lds, pol, kwid); }
            else if (s == 5) { norm_phase(outp, hc, p.g_ffn + l * 1024, modl, 3, 4, abuf, G, lastl ? MLAT : MTOT, kwid); }
            else if (s == 6) { PolUp pol{(const char*)abuf, (const char*)(big + BIG_WUP), p.conv_w + (size_t)l * 3 * 5632, p.conv_b + (size_t)l * 5632, (bf16_t*)(big + BIG_GATED), (bf16_t*)(big + BIG_HB), G, c, nMl, lds + 131072}; gemm_run(lds, pol, kwid); }
            else if (s == 7) { fixup_phase((const bf16_t*)(big + BIG_HB), p.conv_w + (size_t)l * 3 * 5632, p.conv_b + (size_t)l * 5632, (bf16_t*)(big + BIG_GATED), G, lastl ? 512 : 576, kwid); }
            else { PolResid pol{(const char*)(big + BIG_GATED), 5632, (const char*)(big + BIG_WDOWN), 5632, 44, outp, outp, hc, hc, modl, 5, G, c, nMl}; gemm_run(lds, pol, kwid);
                if (!lastl) { conv_run(p, ws, l + 1, 0, 768, tl, swg, snw, kwid); conv_win_fold(p, ws, l + 1, tl, swg, snw, kwid); } }
        }
        if (ph + 1 < ph_hi) {
            if (ph_lo < 0) { __threadfence(); grid.sync(); }
            xcd_barrier((unsigned*)(ws + WS_BAR), xst, (unsigned)G, kwid);
        }
    }
}

extern "C" void kernel_launch(void* const* d_in, const int* in_sizes, int n_in, void* d_out, int out_size, void* d_ws, size_t ws_size, hipStream_t stream) {
    static int grid_blocks = 0;
    if (grid_blocks == 0) {
        if (n_in != 22 || ws_size < WS_END) { fprintf(stderr, "kernel_launch: unexpected n_in %d or ws_size %zu (need %zu)\n", n_in, ws_size, (size_t)WS_END); grid_blocks = -1; return; }
        if (hipFuncSetAttribute((const void*)mega, hipFuncAttributeMaxDynamicSharedMemorySize, LDS_BYTES) != hipSuccess) { fprintf(stderr, "hipFuncSetAttribute failed\n"); grid_blocks = -1; return; }
        int dev = 0, cus = 0, per_cu = 0;
        hipGetDevice(&dev); hipDeviceGetAttribute(&cus, hipDeviceAttributeMultiprocessorCount, dev);
        hipOccupancyMaxActiveBlocksPerMultiprocessor(&per_cu, (const void*)mega, NTHR, LDS_BYTES);
        if (per_cu < 1) { fprintf(stderr, "occupancy query says %d blocks/CU\n", per_cu); per_cu = 1; }
        (void)hipGetLastError();
        grid_blocks = cus;
    }
    if (grid_blocks < 0) return;
    if (hipMemsetAsync((char*)d_ws + WS_BAR, 0, 16384, stream) != hipSuccess) { fprintf(stderr, "memset failed\n"); return; }
    Params p{};
    const float** pp = (const float**)&p;
    for (int i = 0; i < 22; ++i) pp[i] = (const float*)d_in[i];
    p.out = (float*)d_out; p.ws = (unsigned char*)d_ws;
    int lo = 0, hi = NPHASE;
    void* args[] = {&p, &lo, &hi};
    hipError_t e = hipLaunchCooperativeKernel((const void*)mega, dim3(grid_blocks), dim3(NTHR), args, LDS_BYTES, stream);
    if (e != hipSuccess) fprintf(stderr, "cooperative launch failed: %s (grid %d)\n", hipGetErrorString(e), grid_blocks);
}
```

```cpp
#include <hip/hip_runtime.h>
#include <hip/hip_cooperative_groups.h>
#include <cstdio>
namespace cg = cooperative_groups;

#define LAS __attribute__((address_space(3)))
__device__ __forceinline__ int mytid_(int kwid) { int z = 0; asm volatile("" : "+v"(z)); return kwid * 64 + (int)__builtin_amdgcn_mbcnt_hi(~0u, __builtin_amdgcn_mbcnt_lo(~0u, (unsigned)z)); }
#define TIDX mytid_(kwid)
typedef unsigned short bf16_t;
typedef short bf16x8 __attribute__((ext_vector_type(8)));
typedef float f32x4 __attribute__((ext_vector_type(4)));
typedef unsigned u32x4 __attribute__((ext_vector_type(4)));
typedef unsigned u32x2 __attribute__((ext_vector_type(2)));

constexpr int D = 1024, NB = 16, SEQ = 2048, CTXL = 256, DEPTH = 4;
constexpr int MLAT = NB * SEQ, MCTX = NB * CTXL, MTOT = MLAT + MCTX;
constexpr int DFF = 2816, PROJW = 6656;
constexpr int NTHR = 512;
constexpr int LDS_BYTES = 147456;

constexpr size_t WS_WB = 0;
constexpr size_t WB_BYTES = 11534336;
constexpr size_t WS_DMAT = WS_WB + WB_BYTES;
constexpr size_t WS_DC = WS_DMAT + 16777216;
constexpr size_t WS_HC = WS_DC + 262144;
constexpr size_t WS_MOD = WS_HC + 16777216;
constexpr size_t WS_ROPE = WS_MOD + 1671168;
constexpr size_t WS_LAM = WS_ROPE + 8192;
constexpr size_t WS_ABUF = WS_LAM + 256;
constexpr size_t WS_BR = WS_ABUF + 75497472;
constexpr size_t WS_BIG = WS_BR + 113246208;
constexpr size_t BIG_PROJ = 0;
constexpr size_t BIG_T = 150994944;
constexpr size_t BIG_TC = BIG_T + 67108864;
constexpr size_t BIG_VTB = BIG_TC + 8388608;
constexpr size_t BIG_VTC = BIG_VTB + 37748736;
constexpr size_t BIG_BYTES = BIG_VTC + 37748736;
constexpr size_t BIG_MERGED = 0;
constexpr size_t BIG_GSCR = 75497472;
constexpr size_t BIG_SSCR = BIG_GSCR + 33554432;
constexpr size_t BIG_GATED = 0;
constexpr size_t BIG_HB = 207618048;
constexpr size_t BIG_WUP = 233570304;
constexpr size_t BIG_WDOWN = BIG_WUP + 11534336;
static_assert(BIG_WDOWN + 5767168 <= BIG_BYTES, "big");
constexpr size_t BIG_MODPART = 0;
constexpr size_t WS_BAR = WS_BIG + BIG_BYTES;
constexpr size_t WS_END = WS_BAR + 16384;
static_assert(WS_END <= 541745280ull, "workspace");

struct Params {
    const float *x, *c, *ctx, *c_ctx, *w_ada, *b_ada, *g_mix, *g_ffn, *w_in, *b_gate, *w_a, *lam, *subln_g, *w_b, *rpb, *w_c, *w_out, *w_up, *conv_w, *conv_b, *w_down, *g_final;
    float* out; unsigned char* ws;
};

__device__ __forceinline__ unsigned cvt_pk_bf16(float lo, float hi) { unsigned r; asm volatile("v_cvt_pk_bf16_f32 %0, %1, %2" : "=v"(r) : "v"(lo), "v"(hi)); return r; }
__device__ __forceinline__ int lv(int x) { asm volatile("" : "+v"(x)); return x; }
__device__ __forceinline__ int lsg(int x) { asm volatile("" : "+s"(x)); return x; }
__device__ __forceinline__ float bperm(float v, int srclane) { return __int_as_float(__builtin_amdgcn_ds_bpermute(srclane << 2, __float_as_int(v))); }
template <class T> __device__ __forceinline__ T* lptr(T* x) { asm volatile("" : "+s"(x)); return x; }
__device__ __forceinline__ unsigned xb_ld_(unsigned* p) { return __hip_atomic_load(p, __ATOMIC_RELAXED, __HIP_MEMORY_SCOPE_AGENT); }
__device__ __forceinline__ float bf2f(unsigned short b) { return __uint_as_float(((unsigned)b) << 16); }
__device__ __forceinline__ u32x2 pack4(f32x4 v) { u32x2 w; w.x = cvt_pk_bf16(v[0], v[1]); w.y = cvt_pk_bf16(v[2], v[3]); return w; }
__device__ __forceinline__ f32x4 unpack4(u32x2 w) { f32x4 v; v[0] = __uint_as_float(w.x << 16); v[1] = __uint_as_float(w.x & 0xffff0000u); v[2] = __uint_as_float(w.y << 16); v[3] = __uint_as_float(w.y & 0xffff0000u); return v; }

constexpr int HTB = 128 * 64 * 2;
__device__ __forceinline__ int lds_byte(int r, int c) { const int st = (r >> 4) * 2 + (c >> 5), rr = r & 15, cc = c & 31, ob = rr * 64 + cc * 2; return st * 1024 + (ob ^ (((ob >> 9) & 1) << 5)); }
__device__ __forceinline__ void stage_rc(int b, int& R, int& C) { const int st = b / 1024, sb = b % 1024, swz = sb ^ (((sb >> 9) & 1) << 5); R = (st >> 1) * 16 + swz / 64; C = (st & 1) * 32 + (swz % 64) / 2; }

struct UnitD { const char* A; const char* B; int lda, ldb, nt; int pm, pn, kind, br; };

__device__ __forceinline__ bool tile_order(long L, int nM, int nN, int& pm, int& pn) {
    const int nwg = nM * nN; if (L >= nwg) return false;
    int wgid = (int)L; { const int q = nwg / 8, r = nwg % 8, xcd = wgid % 8, off = wgid / 8; wgid = (xcd < r ? xcd * (q + 1) : r * (q + 1) + (xcd - r) * q) + off; }
    const int nig = 8 * nN, gid = wgid / nig, fm = gid * 8, gsz = (nM - fm) < 8 ? (nM - fm) : 8;
    pm = fm + ((wgid % nig) % gsz); pn = (wgid % nig) / gsz; return true;
}

template <class P>
__device__ __forceinline__ void gemm_run(LAS unsigned char* lds, const P& pol, int kwid) {
    const int tid = lv(TIDX), wid = __builtin_amdgcn_readfirstlane(tid >> 6), lane = tid & 63, wr = wid >> 2, wc = wid & 3, fr = lane & 15, fq = lane >> 4;
    int R0_, C0_; { int R, C; stage_rc(tid * 16, R, C); R0_ = R; C0_ = C * 2; }
    const unsigned ldsw = (unsigned)wid * 1024u;
    const int aoff = lds_byte(wr * 64 + fr, fq * 8), boff = lds_byte(wc * 32 + fr, fq * 8);
#define G_SA(b, h) (((b) * 2 + (h)) * HTB)
#define G_SB(b, h) ((4 + (b) * 2 + (h)) * HTB)
#define G_STAGE(bufoff, gbase, ld) do { const unsigned _vo = (unsigned)(R0_ * (ld) + C0_); \
        __builtin_amdgcn_global_load_lds((const unsigned*)((const char*)(gbase) + _vo), (LAS unsigned*)(lds + (bufoff) + ldsw), 16, 0, 0); \
        __builtin_amdgcn_global_load_lds((const unsigned*)((const char*)(gbase) + 64 * (ld) + _vo), (LAS unsigned*)(lds + (bufoff) + ldsw + 8192), 16, 0, 0); } while (0)
#define G_LDA(dst, b, h) do { _Pragma("unroll") for (int m = 0; m < 4; ++m) _Pragma("unroll") for (int k = 0; k < 2; ++k) dst[m][k] = *(const LAS bf16x8*)(lds + G_SA(b, h) + aoff + m * 2048 + k * 1024); } while (0)
#define G_LDB(dst, b, h) do { _Pragma("unroll") for (int n = 0; n < 2; ++n) _Pragma("unroll") for (int k = 0; k < 2; ++k) dst[n][k] = *(const LAS bf16x8*)(lds + G_SB(b, h) + boff + n * 2048 + k * 1024); } while (0)
#define G_MMA(ai, bj, At, Bt) do { __builtin_amdgcn_s_setprio(1); _Pragma("unroll") for (int m = 0; m < 4; ++m) _Pragma("unroll") for (int n = 0; n < 2; ++n) _Pragma("unroll") for (int k = 0; k < 2; ++k) \
        acc[ai][bj][m][n] = __builtin_amdgcn_mfma_f32_16x16x32_bf16(Bt[n][k], At[m][k], acc[ai][bj][m][n], 0, 0, 0); __builtin_amdgcn_s_setprio(0); } while (0)
#define G_WAIT_V(n) asm volatile("s_waitcnt vmcnt(" #n ")" ::: "memory")
#define G_WAIT_L(n) asm volatile("s_waitcnt lgkmcnt(" #n ")" ::: "memory")
#define G_BAR __builtin_amdgcn_s_barrier()
#define G_SCHED __builtin_amdgcn_sched_barrier(0)
    UnitD cur, nxt; int ui = 0;
    if (!pol.unit(0, cur)) return;
    if constexpr (P::HANDOFF) pol.a_ready(cur, kwid);
    f32x4 acc[2][2][4][2];
#pragma unroll
    for (int a = 0; a < 2; ++a)
#pragma unroll
        for (int b = 0; b < 2; ++b)
#pragma unroll
            for (int m = 0; m < 4; ++m)
#pragma unroll
                for (int n = 0; n < 2; ++n) acc[a][b][m][n] = (f32x4){0.f, 0.f, 0.f, 0.f};
    bf16x8 At[4][2], B0[2][2], B1[2][2];
    const char* cA = cur.A; const char* cB = cur.B; int lda = cur.lda, ldb = cur.ldb;
    G_STAGE(G_SB(0, 0), cB, ldb); G_STAGE(G_SA(0, 0), cA, lda); G_STAGE(G_SB(0, 1), cB + 128 * ldb, ldb); G_STAGE(G_SA(0, 1), cA + 128 * lda, lda);
    if (wr == 1) G_BAR;
    G_WAIT_V(4); G_BAR;
    G_STAGE(G_SB(1, 0), cB + 128, ldb); G_STAGE(G_SA(1, 0), cA + 128, lda); G_STAGE(G_SB(1, 1), cB + 128 * ldb + 128, ldb);
    G_WAIT_V(6); G_BAR;
    for (;;) {
        const bool has_next = pol.unit(ui + 1, nxt);
        const char* nA = has_next ? nxt.A : cA; const char* nB = has_next ? nxt.B : cB;
        const int nlda = has_next ? nxt.lda : lda, nldb = has_next ? nxt.ldb : ldb;
        const int nt = cur.nt;
        for (int t = 0; t < nt; t += 2) {
            const bool last = (t == nt - 2);
            const char* a1 = cA + (size_t)(t + 1) * 128;
            const char* a2 = last ? nA : cA + (size_t)(t + 2) * 128; const char* b2 = last ? nB : cB + (size_t)(t + 2) * 128;
            const int la2 = last ? nlda : lda, lb2 = last ? nldb : ldb;
            const char* a3 = a2 + 128; const char* b3 = b2 + 128;
            if constexpr (P::HANDOFF) { if (last && has_next) pol.a_ready(nxt, kwid); }
            G_LDB(B0, 0, 0); G_SCHED; G_LDA(At, 0, 0); G_STAGE(G_SA(1, 1), a1 + 128 * lda, lda);
            G_WAIT_L(8); G_BAR; G_WAIT_L(0); G_MMA(0, 0, At, B0); G_BAR; G_SCHED;
            G_LDB(B1, 0, 1); G_STAGE(G_SB(0, 0), b2, lb2);
            G_BAR; G_WAIT_L(0); G_MMA(0, 1, At, B1); G_BAR;
            G_LDA(At, 0, 1); G_STAGE(G_SA(0, 0), a2, la2);
            G_BAR; G_WAIT_L(0); G_MMA(1, 0, At, B0); G_BAR; G_SCHED;
            G_STAGE(G_SB(0, 1), b2 + 128 * lb2, lb2);
            G_WAIT_V(6); G_BAR; G_MMA(1, 1, At, B1); G_BAR;
            G_LDB(B0, 1, 0); G_SCHED; G_LDA(At, 1, 0); G_STAGE(G_SA(0, 1), a2 + 128 * la2, la2);
            G_WAIT_L(8); G_BAR; G_WAIT_L(0); G_MMA(0, 0, At, B0); G_BAR; G_SCHED;
            G_LDB(B1, 1, 1); G_STAGE(G_SB(1, 0), b3, lb2);
            G_BAR; G_WAIT_L(0); G_MMA(0, 1, At, B1); G_BAR;
            G_LDA(At, 1, 1); G_STAGE(G_SA(1, 0), a3, la2);
            G_BAR; G_WAIT_L(0); G_MMA(1, 0, At, B0); G_BAR; G_SCHED;
            G_STAGE(G_SB(1, 1), b3 + 128 * lb2, lb2);
            G_WAIT_V(6); G_BAR; G_MMA(1, 1, At, B1); G_BAR;
        }
        { const int t2 = lv(TIDX); pol.epi(acc, cur, wr, wc, t2 & 15, (t2 >> 4) & 3, t2); }
        if (!has_next) break;
#pragma unroll
        for (int a = 0; a < 2; ++a)
#pragma unroll
            for (int b = 0; b < 2; ++b)
#pragma unroll
                for (int m = 0; m < 4; ++m)
#pragma unroll
                    for (int n = 0; n < 2; ++n) acc[a][b][m][n] = (f32x4){0.f, 0.f, 0.f, 0.f};
        cur = nxt; cA = nA; cB = nB; lda = nlda; ldb = nldb; ++ui;
    }
    G_WAIT_V(0);
    if (wr == 0) G_BAR;
    G_BAR;
#undef G_SA
#undef G_SB
#undef G_STAGE
#undef G_LDA
#undef G_LDB
#undef G_MMA
}

__device__ __forceinline__ f32x4 sel4(bool c, f32x4 a, f32x4 b) { f32x4 r; r[0] = c ? a[0] : b[0]; r[1] = c ? a[1] : b[1]; r[2] = c ? a[2] : b[2]; r[3] = c ? a[3] : b[3]; return r; }
__device__ __forceinline__ f32x4 ldg4(const void* base, unsigned off) { return *(const f32x4*)((const char*)base + (size_t)off); }
__device__ __forceinline__ void stg2(void* base, unsigned off, u32x2 v) { *(u32x2*)((char*)base + (size_t)off) = v; }
typedef f32x4 Acc[2][2][4][2];

struct PolInProj {
    static constexpr bool HANDOFF = false;
    const char* abuf; const char* wt; bf16_t* proj; bf16_t* T; bf16_t* Tc; bf16_t* VtB; bf16_t* VtC; const LAS unsigned char* ropel; int G, c; int nostore;
    __device__ __forceinline__ bool unit(int i, UnitD& u) const {
        int pm, pn; if (!tile_order((long)i * G + c, 144, 16, pm, pn)) return false;
        u.pm = pm; u.pn = pn; u.lda = 2048; u.ldb = 2048; u.nt = 16; u.br = 0;
        const bool sw = (pn < 4) || (pn >= 12); u.kind = sw ? 1 : 0;
        const char* act = abuf + (size_t)pm * 256 * 2048; const char* w = wt + (size_t)pn * 256 * 2048;
        u.A = sw ? w : act; u.B = sw ? act : w; return true;
    }
    __device__ __forceinline__ void epi(Acc& acc, const UnitD& u, int wr, int wc, int fr, int fq, int tid) const {
        const int pm = u.pm, pn = u.pn;
        if (nostore) { float sink = 0.f; for (int a = 0; a < 2; ++a) for (int b = 0; b < 2; ++b) for (int m = 0; m < 4; ++m) for (int n = 0; n < 2; ++n) sink += acc[a][b][m][n][0] + acc[a][b][m][n][1] + acc[a][b][m][n][2] + acc[a][b][m][n][3]; if (sink == 123.456f) proj[0] = 0; return; }
        if (u.kind) {
            const bool lat = pm < 128; const int b = lat ? (pm >> 3) : (pm - 128);
            bf16_t* base; int rowlen;
            if (pn < 4) { const int part = pn >> 1, col0 = (pn & 1) * 256;
                if (lat) { base = T + ((size_t)(b * 512 + col0) * 4096 + part * 2048 + (pm & 7) * 256); rowlen = 4096; }
                else { base = Tc + ((size_t)(b * 512 + col0) * 512 + part * 256); rowlen = 512; } }
            else { bf16_t* vt = (pn < 14) ? VtB : VtC; const int col0 = (pn & 1) * 256;
                base = vt + ((size_t)(b * 512 + col0) * 2304 + (lat ? (pm & 7) * 256 : 2048)); rowlen = 2304; }
            if (pn < 14) {
#pragma unroll
                for (int ai = 0; ai < 2; ++ai)
#pragma unroll
                    for (int m = 0; m < 4; ++m) { const int r = ai * 128 + wr * 64 + m * 16 + fr; bf16_t* rp = base + (size_t)r * rowlen + wc * 32 + 8 * fq;
#pragma unroll
                        for (int bj = 0; bj < 2; ++bj) { const u32x2 p0 = pack4(acc[ai][bj][m][0]), p1 = pack4(acc[ai][bj][m][1]); u32x4 w; w.x = p0.x; w.y = p0.y; w.z = p1.x; w.w = p1.y; *(u32x4*)(rp + bj * 128) = w; } }
            } else {
#pragma unroll
                for (int ai = 0; ai < 2; ++ai)
#pragma unroll
                    for (int m = 0; m < 4; ++m) { const int r = ai * 128 + wr * 64 + m * 16 + fr; bf16_t* rp = base + (size_t)r * rowlen + wc * 32 + 4 * fq;
#pragma unroll
                        for (int bj = 0; bj < 2; ++bj)
#pragma unroll
                            for (int n = 0; n < 2; ++n) *(u32x2*)(rp + bj * 128 + n * 16) = pack4(acc[ai][bj][m][n]); }
            }
        } else {
            const bool dorope = (pn < 8) && (pm < 128); const float sc = (pn == 4 || pn == 5 || pn == 8 || pn == 9) ? 0.125f : 1.0f;
            const int colbase = (pn - 4) * 256 + wc * 32 + 8 * fq; const int axis = wc & 1;
#pragma unroll
            for (int ai = 0; ai < 2; ++ai)
#pragma unroll
                for (int m = 0; m < 4; ++m) { const int r = ai * 128 + wr * 64 + m * 16 + fr; const int tok = pm * 256 + r; const int t = tok & 2047;
                    const int pos = axis ? (t & 63) : (t >> 6);
                    f32x4 cs = (f32x4){1.f, 1.f, 1.f, 1.f}, sn = (f32x4){0.f, 0.f, 0.f, 0.f};
                    if (dorope) { cs = *(const LAS f32x4*)(ropel + (pos * 16 + 4 * fq) * 4); sn = *(const LAS f32x4*)(ropel + 4096 + (pos * 16 + 4 * fq) * 4); }
                    bf16_t* rp = proj + (size_t)tok * 2048 + colbase;
#pragma unroll
                    for (int bj = 0; bj < 2; ++bj) { const f32x4 a = acc[ai][bj][m][0], bb = acc[ai][bj][m][1];
                        const f32x4 o0 = (a * cs - bb * sn) * sc, o1 = (a * sn + bb * cs) * sc;
                        const u32x2 p0 = pack4(o0), p1 = pack4(o1); u32x4 w; w.x = p0.x; w.y = p0.y; w.z = p1.x; w.w = p1.y; *(u32x4*)(rp + bj * 128) = w; } }
        }
    }
};

struct PolDft {
    static constexpr bool HANDOFF = false;
    const char* dmat; const char* dc; const char* T; const char* Tc; bf16_t* br; int G, c, nU;
    __device__ __forceinline__ bool unit(int i, UnitD& u) const {
        const long L = (long)i * G + c; if (L >= nU) return false;
        if (L < 256) { const int b = (int)L >> 4, pm = ((int)L >> 1) & 7, pn = (int)L & 1;
            u.A = dmat + (size_t)pm * 256 * 8192; u.lda = 8192; u.B = T + ((size_t)(b * 512 + pn * 256) * 4096) * 2; u.ldb = 8192; u.nt = 64; u.pm = b * 8 + pm; u.pn = pn; u.kind = 0; }
        else { const int b = ((int)L - 256) >> 1, pn = (int)L & 1;
            u.A = dc; u.lda = 1024; u.B = Tc + ((size_t)(b * 512 + pn * 256) * 512) * 2; u.ldb = 1024; u.nt = 8; u.pm = 128 + b; u.pn = pn; u.kind = 1; }
        u.br = 0; return true;
    }
    __device__ __forceinline__ void epi(Acc& acc, const UnitD& u, int wr, int wc, int fr, int fq, int tid) const {
        const float sc = u.kind ? 0.0055242717280199f : 0.001953125f;
#pragma unroll
        for (int ai = 0; ai < 2; ++ai)
#pragma unroll
            for (int m = 0; m < 4; ++m) { const int r = ai * 128 + wr * 64 + m * 16 + fr; bf16_t* rp = br + (size_t)(u.pm * 256 + r) * 1536 + u.pn * 256 + wc * 32 + 4 * fq;
#pragma unroll
                for (int bj = 0; bj < 2; ++bj)
#pragma unroll
                    for (int n = 0; n < 2; ++n) *(u32x2*)(rp + bj * 128 + n * 16) = pack4(acc[ai][bj][m][n] * sc); }
    }
};

struct PolMerge {
    static constexpr bool HANDOFF = false;
    const char* abuf; const char* brb; const char* wm; const float* bgate; u32x4* gscr; f32x4* sscr; bf16_t* merged; int G, c, nM;
    __device__ __forceinline__ bool unit(int i, UnitD& u) const {
        const int ti = i / 6, s = i - ti * 6; int pm, pn; if (!tile_order((long)ti * G + c, nM, 4, pm, pn)) return false;
        const int br = s >> 1; u.pm = pm; u.pn = pn; u.br = br; u.kind = s & 1; u.ldb = 3072;
        if (!(s & 1)) { u.A = abuf + (size_t)pm * 256 * 2048; u.lda = 2048; u.B = wm + ((size_t)(br * 1024 + pn * 256) * 1536) * 2; u.nt = 16; }
        else { u.A = brb + ((size_t)pm * 256 * 1536 + br * 512) * 2; u.lda = 3072; u.B = wm + ((size_t)(br * 1024 + pn * 256) * 1536 + 1024) * 2; u.nt = 8; }
        return true;
    }
    __device__ __forceinline__ void epi(Acc& acc, const UnitD& u, int wr, int wc, int fr, int fq, int tid) const {
        u32x4* gs = gscr + (size_t)blockIdx.x * 16 * 512 + tid; u32x4* ss = (u32x4*)sscr + (size_t)blockIdx.x * 16 * 512 + tid;
        if (u.kind == 0) {
            const float* bp = bgate + u.br * 1024 + u.pn * 256 + wc * 32 + 4 * fq;
#pragma unroll
            for (int bj = 0; bj < 2; ++bj) { const f32x4 b0 = *(const f32x4*)(bp + bj * 128), b1 = *(const f32x4*)(bp + bj * 128 + 16);
#pragma unroll
                for (int ai = 0; ai < 2; ++ai)
#pragma unroll
                    for (int m = 0; m < 4; ++m) { f32x4 v0 = acc[ai][bj][m][0] + b0, v1 = acc[ai][bj][m][1] + b1;
#pragma unroll
                        for (int j = 0; j < 4; ++j) { v0[j] = __builtin_amdgcn_rcpf(1.0f + __expf(-v0[j])); v1[j] = __builtin_amdgcn_rcpf(1.0f + __expf(-v1[j])); }
                        const u32x2 p0 = pack4(v0), p1 = pack4(v1); u32x4 w; w.x = p0.x; w.y = p0.y; w.z = p1.x; w.w = p1.y;
                        gs[((ai * 2 + bj) * 4 + m) * 512] = w; asm volatile("" ::: "memory"); } }
        } else {
            u32x4* sb = (u32x4*)ss;
            const f32x4 z4 = (f32x4){0.f, 0.f, 0.f, 0.f}; const bool addS = u.br > 0;
#pragma unroll
            for (int ai = 0; ai < 2; ++ai) {
                u32x4 gw[4][2], sw[4][2];
#pragma unroll
                for (int m = 0; m < 4; ++m)
#pragma unroll
                    for (int bj = 0; bj < 2; ++bj) { const int gi = ((ai * 2 + bj) * 4 + m); gw[m][bj] = gs[gi * 512]; sw[m][bj] = sb[gi * 512]; }
                asm volatile("" ::: "memory");
#pragma unroll
                for (int m = 0; m < 4; ++m) { const int r = ai * 128 + wr * 64 + m * 16 + fr; bf16_t* rp = merged + (size_t)(u.pm * 256 + r) * 1024 + u.pn * 256 + wc * 32 + 4 * fq;
#pragma unroll
                    for (int bj = 0; bj < 2; ++bj) { const int gi = ((ai * 2 + bj) * 4 + m); const u32x4 w = gw[m][bj], q = sw[m][bj];
                        u32x2 p0; p0.x = w.x; p0.y = w.y; u32x2 p1; p1.x = w.z; p1.y = w.w; u32x2 q0; q0.x = q.x; q0.y = q.y; u32x2 q1; q1.x = q.z; q1.y = q.w;
                        const f32x4 v0 = unpack4(p0) * acc[ai][bj][m][0] + sel4(addS, unpack4(q0), z4), v1 = unpack4(p1) * acc[ai][bj][m][1] + sel4(addS, unpack4(q1), z4);
                        const u32x2 o0 = pack4(v0), o1 = pack4(v1);
                        if (u.br < 2) { u32x4 o; o.x = o0.x; o.y = o0.y; o.z = o1.x; o.w = o1.y; sb[gi * 512] = o; }
                        else { *(u32x2*)(rp + bj * 128) = o0; *(u32x2*)(rp + bj * 128 + 16) = o1; } } }
                asm volatile("" ::: "memory");
            }
        }
    }
};

struct PolResid {
    static constexpr bool HANDOFF = false;
    const char* A; int lda; const char* wt; int ldb; int nt; const float* hx_in; float* hx_out; const float* hc_in; float* hc_out; const float* modl; int gidx; int G, c, nM;
    __device__ __forceinline__ bool unit(int i, UnitD& u) const {
        int pm, pn; if (!tile_order((long)i * G + c, nM, 4, pm, pn)) return false;
        u.pm = pm; u.pn = pn; u.kind = 0; u.br = 0; u.lda = lda; u.ldb = ldb; u.nt = nt;
        u.A = A + (size_t)pm * 256 * lda; u.B = wt + (size_t)pn * 256 * ldb; return true;
    }
    __device__ __forceinline__ void epi(Acc& acc, const UnitD& u, int wr, int wc, int fr, int fq, int tid) const {
        const bool lat = u.pm < 128; const int brow = lat ? (u.pm >> 3) : 16;
        const float* hin = lat ? hx_in + (size_t)u.pm * 256 * 1024 : hc_in + (size_t)(u.pm - 128) * 256 * 1024;
        float* hout = lat ? hx_out + (size_t)u.pm * 256 * 1024 : hc_out + (size_t)(u.pm - 128) * 256 * 1024;
        const int col0 = u.pn * 256 + wc * 32 + 4 * fq;
        const float* gp = modl + (size_t)brow * 6144 + gidx * 1024 + col0;
#pragma unroll
        for (int bj = 0; bj < 2; ++bj)
#pragma unroll
            for (int n = 0; n < 2; ++n) { const f32x4 g = *(const f32x4*)(gp + bj * 128 + n * 16);
#pragma unroll
                for (int ai = 0; ai < 2; ++ai)
#pragma unroll
                    for (int m = 0; m < 4; ++m) { const int r = ai * 128 + wr * 64 + m * 16 + fr; const unsigned off = (unsigned)(r * 1024 + col0 + bj * 128 + n * 16) * 4u;
                        acc[ai][bj][m][n] = ldg4(hin, off) + g * acc[ai][bj][m][n]; } }
        asm volatile("" ::: "memory");
#pragma unroll
        for (int ai = 0; ai < 2; ++ai)
#pragma unroll
            for (int m = 0; m < 4; ++m)
#pragma unroll
                for (int bj = 0; bj < 2; ++bj)
#pragma unroll
                    for (int n = 0; n < 2; ++n) { const int r = ai * 128 + wr * 64 + m * 16 + fr; const unsigned off = (unsigned)(r * 1024 + col0 + bj * 128 + n * 16) * 4u;
                        *(f32x4*)((char*)hout + (size_t)off) = acc[ai][bj][m][n]; }
    }
};


struct PolMW {
    static constexpr bool HANDOFF = true;
    const char* abuf; const char* brb; const char* wm; const float* bgate; u32x4* gscr; f32x4* sscr; bf16_t* merged;
    const char* wtout; const float* hx_in; float* hx_out; const float* hc_in; float* hc_out; const float* modl; unsigned* cnt; unsigned target; int G, c, nM;
    __device__ __forceinline__ void tile_of(int q, int& pm, int& pn) const { if (q < 512) tile_order(q, 128, 4, pm, pn); else { pm = 128 + ((q - 512) >> 2); pn = (q - 512) & 3; } }
    __device__ __forceinline__ bool unit(int i, UnitD& u) const {
        const bool ctxl = (nM == 144); const int nmt = (ctxl && c < 64) ? 3 : 2;
        if (i < nmt * 6) { const int ti = i / 6, s = i - ti * 6; int pm, pn; tile_of(ti < 2 ? ti * 256 + c : 512 + c, pm, pn);
            const int br = s >> 1; u.pm = pm; u.pn = pn; u.br = br; u.kind = s & 1; u.ldb = 3072;
            if (!(s & 1)) { u.A = abuf + (size_t)pm * 256 * 2048; u.lda = 2048; u.B = wm + ((size_t)(br * 1024 + pn * 256) * 1536) * 2; u.nt = 16; }
            else { u.A = brb + ((size_t)pm * 256 * 1536 + br * 512) * 2; u.lda = 3072; u.B = wm + ((size_t)(br * 1024 + pn * 256) * 1536 + 1024) * 2; u.nt = 8; }
            return true; }
        const int k = i - nmt * 6; int q;
        if (ctxl) { if (c < 64 || k >= 3) return false; q = (c - 64) + 192 * k; } else { if (k >= 2) return false; q = c + 256 * k; }
        int pm, pn; tile_of(q, pm, pn); u.pm = pm; u.pn = pn; u.br = 0; u.kind = 2; u.lda = 2048; u.ldb = 2048; u.nt = 16;
        u.A = (const char*)merged + (size_t)pm * 256 * 2048; u.B = wtout + (size_t)pn * 256 * 2048; return true;
    }
    __device__ __forceinline__ void a_ready(const UnitD& u, int kwid) const {
        if (u.kind != 2) return;
        if (kwid == 0) { unsigned sp = 0; while (xb_ld_(cnt + u.pm) < target) { __builtin_amdgcn_s_sleep(2); if (++sp > (1u << 22)) break; }
            __builtin_amdgcn_fence(__ATOMIC_ACQUIRE, "agent"); asm volatile("s_waitcnt vmcnt(0)" ::: "memory"); }
        asm volatile("" ::: "memory"); __builtin_amdgcn_s_barrier(); asm volatile("" ::: "memory");
    }
    __device__ __forceinline__ void epi(Acc& acc, const UnitD& u, int wr, int wc, int fr, int fq, int tid) const {
        u32x4* gs = gscr + (size_t)blockIdx.x * 16 * 512 + tid; u32x4* sb = (u32x4*)sscr + (size_t)blockIdx.x * 16 * 512 + tid;
        if (u.kind == 0) {
            const float* bp = bgate + u.br * 1024 + u.pn * 256 + wc * 32 + 4 * fq;
#pragma unroll
            for (int bj = 0; bj < 2; ++bj) { const f32x4 b0 = *(const f32x4*)(bp + bj * 128), b1 = *(const f32x4*)(bp + bj * 128 + 16);
#pragma unroll
                for (int ai = 0; ai < 2; ++ai)
#pragma unroll
                    for (int m = 0; m < 4; ++m) { f32x4 v0 = acc[ai][bj][m][0] + b0, v1 = acc[ai][bj][m][1] + b1;
#pragma unroll
                        for (int j = 0; j < 4; ++j) { v0[j] = __builtin_amdgcn_rcpf(1.0f + __expf(-v0[j])); v1[j] = __builtin_amdgcn_rcpf(1.0f + __expf(-v1[j])); }
                        const u32x2 p0 = pack4(v0), p1 = pack4(v1); u32x4 w; w.x = p0.x; w.y = p0.y; w.z = p1.x; w.w = p1.y;
                        gs[((ai * 2 + bj) * 4 + m) * 512] = w; asm volatile("" ::: "memory"); } }
        } else if (u.kind == 1) {
            const f32x4 z4 = (f32x4){0.f, 0.f, 0.f, 0.f}; const bool addS = u.br > 0;
#pragma unroll
            for (int ai = 0; ai < 2; ++ai) {
                u32x4 gw[4][2], sw[4][2];
#pragma unroll
                for (int m = 0; m < 4; ++m)
#pragma unroll
                    for (int bj = 0; bj < 2; ++bj) { const int gi = ((ai * 2 + bj) * 4 + m); gw[m][bj] = gs[gi * 512]; sw[m][bj] = sb[gi * 512]; }
                asm volatile("" ::: "memory");
#pragma unroll
                for (int m = 0; m < 4; ++m) { const int r = ai * 128 + wr * 64 + m * 16 + fr; bf16_t* rp = merged + (size_t)(u.pm * 256 + r) * 1024 + u.pn * 256 + wc * 32 + 4 * fq;
#pragma unroll
                    for (int bj = 0; bj < 2; ++bj) { const int gi = ((ai * 2 + bj) * 4 + m); const u32x4 w = gw[m][bj], q = sw[m][bj];
                        u32x2 p0; p0.x = w.x; p0.y = w.y; u32x2 p1; p1.x = w.z; p1.y = w.w; u32x2 q0; q0.x = q.x; q0.y = q.y; u32x2 q1; q1.x = q.z; q1.y = q.w;
                        const f32x4 v0 = unpack4(p0) * acc[ai][bj][m][0] + sel4(addS, unpack4(q0), z4), v1 = unpack4(p1) * acc[ai][bj][m][1] + sel4(addS, unpack4(q1), z4);
                        const u32x2 o0 = pack4(v0), o1 = pack4(v1);
                        if (u.br < 2) { u32x4 o; o.x = o0.x; o.y = o0.y; o.z = o1.x; o.w = o1.y; sb[gi * 512] = o; }
                        else {
                            __hip_atomic_store((unsigned long long*)(rp + bj * 128), ((unsigned long long)o0.y << 32) | (unsigned long long)o0.x, __ATOMIC_RELAXED, __HIP_MEMORY_SCOPE_AGENT);
                            __hip_atomic_store((unsigned long long*)(rp + bj * 128 + 16), ((unsigned long long)o1.y << 32) | (unsigned long long)o1.x, __ATOMIC_RELAXED, __HIP_MEMORY_SCOPE_AGENT); } } }
                asm volatile("" ::: "memory");
            }
            if (u.br == 2) { asm volatile("s_waitcnt vmcnt(0)" ::: "memory"); if ((tid & 63) == 0) __hip_atomic_fetch_add(cnt + u.pm, 1u, __ATOMIC_RELAXED, __HIP_MEMORY_SCOPE_AGENT); }
        } else {
            const bool lat = u.pm < 128; const int brow = lat ? (u.pm >> 3) : 16;
            const float* hin = lat ? hx_in + (size_t)u.pm * 256 * 1024 : hc_in + (size_t)(u.pm - 128) * 256 * 1024;
            float* hout = lat ? hx_out + (size_t)u.pm * 256 * 1024 : hc_out + (size_t)(u.pm - 128) * 256 * 1024;
            const int col0 = u.pn * 256 + wc * 32 + 4 * fq;
            const float* gp = modl + (size_t)brow * 6144 + 2 * 1024 + col0;
            f32x4 gv[2][2];
#pragma unroll
            for (int bj = 0; bj < 2; ++bj)
#pragma unroll
                for (int n = 0; n < 2; ++n) gv[bj][n] = *(const f32x4*)(gp + bj * 128 + n * 16);
#pragma unroll
            for (int ai = 0; ai < 2; ++ai) {
                f32x4 hv[4][2][2];
#pragma unroll
                for (int m = 0; m < 4; ++m)
#pragma unroll
                    for (int bj = 0; bj < 2; ++bj)
#pragma unroll
                        for (int n = 0; n < 2; ++n) { const int r = ai * 128 + wr * 64 + m * 16 + fr; hv[m][bj][n] = ldg4(hin, (unsigned)(r * 1024 + col0 + bj * 128 + n * 16) * 4u); }
                asm volatile("" ::: "memory");
#pragma unroll
                for (int m = 0; m < 4; ++m)
#pragma unroll
                    for (int bj = 0; bj < 2; ++bj)
#pragma unroll
                        for (int n = 0; n < 2; ++n) { const int r = ai * 128 + wr * 64 + m * 16 + fr; const unsigned off = (unsigned)(r * 1024 + col0 + bj * 128 + n * 16) * 4u;
                            *(f32x4*)((char*)hout + (size_t)off) = hv[m][bj][n] + gv[bj][n] * acc[ai][bj][m][n]; }
                asm volatile("" ::: "memory");
            }
        }
    }
};

__device__ __forceinline__ f32x4 rot4(f32x4 v, int src) { f32x4 r; r[0] = bperm(v[0], src); r[1] = bperm(v[1], src); r[2] = bperm(v[2], src); r[3] = bperm(v[3], src); return r; }
struct PolUp {
    static constexpr bool HANDOFF = false;
    const char* abuf; const char* wt; const float* cw; const float* cb; bf16_t* gated; bf16_t* hb; int G, c, nM; LAS unsigned char* ldsx;
    __device__ __forceinline__ bool unit(int i, UnitD& u) const {
        int pm, pn; if (!tile_order((long)i * G + c, nM, 22, pm, pn)) return false;
        u.pm = pm; u.pn = pn; u.kind = 0; u.br = 0; u.lda = 2048; u.ldb = 2048; u.nt = 16;
        u.A = abuf + (size_t)pm * 256 * 2048; u.B = wt + (size_t)pn * 256 * 2048; return true;
    }
    __device__ __forceinline__ void epi(Acc& acc, const UnitD& u, int wr, int wc, int fr, int fq, int tid) const {
        const int lane = tid & 63; const int srcR = (lane & 48) | ((fr + 15) & 15), srcL = (lane & 48) | ((fr + 1) & 15);
        LAS unsigned char* wl = ldsx + (wr * 4 + wc) * 1024;
        { const int arr = lane & 3, fqv = (lane >> 2) & 3, hfv = (lane >> 4) & 1, nv = (lane >> 5) & 1;
          const int cidx = hfv * DFF + u.pn * 128 + wc * 32 + nv * 16 + 4 * fqv;
          const f32x4 v = (arr < 3) ? ldg4(cw, (unsigned)(arr * 2 * DFF + cidx) * 4u) : ldg4(cb, (unsigned)cidx * 4u);
          *(LAS f32x4*)(wl + lane * 16) = v; asm volatile("s_waitcnt lgkmcnt(0)" ::: "memory"); }
#pragma unroll
        for (int n = 0; n < 2; ++n) {
            const int ja = u.pn * 128 + wc * 32 + n * 16 + 4 * fq;
#pragma unroll
            for (int ai = 0; ai < 2; ++ai) {
                const int seg = u.pm * 4 + ai * 2 + wr;
                asm volatile("" : "+v"(acc[ai][0][0][n]), "+v"(acc[ai][0][1][n]), "+v"(acc[ai][0][2][n]), "+v"(acc[ai][0][3][n]), "+v"(acc[ai][1][0][n]), "+v"(acc[ai][1][1][n]), "+v"(acc[ai][1][2][n]), "+v"(acc[ai][1][3][n]) :: "memory");
                f32x4 uv[2][4];
#pragma unroll
                for (int hf = 1; hf >= 0; --hf) {
                    const LAS f32x4* wv = (const LAS f32x4*)(wl + ((n * 2 + hf) * 4 + fq) * 64);
                    const f32x4 w0 = wv[0], w1 = wv[1], w2 = wv[2], bb = wv[3];
                    f32x4 rrp = rot4(acc[ai][hf][0][n], srcR), rlc = rot4(acc[ai][hf][0][n], srcL);
#pragma unroll
                    for (int m = 0; m < 4; ++m) {
                        const f32x4 rrc = (m == 0) ? rrp : rot4(acc[ai][hf][m][n], srcR);
                        const f32x4 rln = (m < 3) ? rot4(acc[ai][hf][m + 1][n], srcL) : rlc;
                        const f32x4 prev = sel4(fr > 0, rrc, rrp);
                        const f32x4 next = sel4(fr < 15, rlc, rln);
                        uv[hf][m] = w0 * prev + w1 * acc[ai][hf][m][n] + w2 * next + bb;
                        rrp = rrc; rlc = rln;
                    }
                    __builtin_amdgcn_sched_barrier(0);
                }
#pragma unroll
                for (int m = 0; m < 4; ++m) {
                    const int r = ai * 128 + wr * 64 + m * 16 + fr;
                    const bool bnd = (m == 0 && fr == 0) || (m == 3 && fr == 15);
                    if (!bnd) { f32x4 g;
#pragma unroll
                        for (int j = 0; j < 4; ++j) { const float a = uv[0][m][j]; g[j] = a * __builtin_amdgcn_rcpf(1.0f + __expf(-a)) * uv[1][m][j]; }
                        stg2(gated, ((unsigned)(u.pm * 256 + r) * (unsigned)DFF + (unsigned)ja) * 2u, pack4(g)); }
                    if (m == 0 && fr < 2) {
#pragma unroll
                        for (int hf = 0; hf < 2; ++hf) stg2(hb, ((unsigned)(seg * 4 + fr) * (unsigned)(2 * DFF) + (unsigned)(hf * DFF + ja)) * 2u, pack4(acc[ai][hf][m][n])); }
                    if (m == 3 && fr >= 14) {
#pragma unroll
                        for (int hf = 0; hf < 2; ++hf) stg2(hb, ((unsigned)(seg * 4 + fr - 12) * (unsigned)(2 * DFF) + (unsigned)(hf * DFF + ja)) * 2u, pack4(acc[ai][hf][m][n])); }
                }
                asm volatile("" ::: "memory"); __builtin_amdgcn_sched_barrier(0);
            }
        }
    }
};

#define SHX(v, mask) bperm((v), lane ^ (mask))
__device__ __forceinline__ float wave_sum(float v, int lane) { v += SHX(v, 32); v += SHX(v, 16); v += SHX(v, 8); v += SHX(v, 4); v += SHX(v, 2); v += SHX(v, 1); return v; }

__device__ __forceinline__ void conv_win_fold(const Params& p, unsigned char* ws, int l, float* tl, int wgi, int nwg, int kwid) {
    const float* src = p.w_in + (size_t)l * D * PROJW; bf16_t* dst = (bf16_t*)(ws + WS_WB);
    float* wsm = tl; float* tw = tl + 64 * 129;
    const int tid = lv(TIDX);
    if (wgi < 0) return;
    for (int it = wgi; it < 256; it += nwg) { const int g = it >> 6, k0 = ((it >> 2) & 15) * 64, cqb = (it & 3) * 32;
        if (tid < 128) { float s, c; sincospif((float)tid / 64.0f, &s, &c); tw[tid] = c; tw[128 + tid] = s; }
        for (int e = tid; e < 64 * 128; e += NTHR) { const int kk = e >> 7, cc = e & 127; wsm[kk * 129 + cc] = src[(size_t)(k0 + kk) * PROJW + g * 128 + cc]; }
        __syncthreads();
        const int kk = tid & 63, cq0 = tid >> 6;
        for (int i = 0; i < 4; ++i) { const int cp = cqb + cq0 + 8 * i; float ac = 0.f, as = 0.f;
            for (int cc = 0; cc < 128; ++cc) { const float w = wsm[kk * 129 + cc]; const int ix = (cc * cp) & 127; ac += w * tw[ix]; as += w * tw[128 + ix]; }
            dst[(size_t)(g * 128 + cp) * 1024 + k0 + kk] = (bf16_t)(cvt_pk_bf16(ac, 0.f) & 0xffff);
            dst[(size_t)(512 + g * 128 + cp) * 1024 + k0 + kk] = (bf16_t)(cvt_pk_bf16(as, 0.f) & 0xffff); }
        __syncthreads(); }
}
struct ConvD { const float* src; int sld, k0, scol0; bf16_t* dst; int dld, drow0, dk0; };
__device__ __forceinline__ ConvD conv_desc(const Params& p, unsigned char* ws, int l, int kind, int it) {
    ConvD d; bf16_t* wb = (bf16_t*)(ws + WS_WB);
    if (kind == 0) { const int rt = it >> 4, kt = it & 15; const int blk = rt >> 3, within = (rt & 7) * 64;
        const int sc0 = (blk == 0 ? 512 : blk == 1 ? 1024 : blk == 2 ? 2048 : blk == 3 ? 2560 : blk == 4 ? 1536 : 3072) + within;
        d.src = p.w_in + (size_t)l * D * PROJW; d.sld = PROJW; d.k0 = kt * 64; d.scol0 = sc0; d.dst = wb; d.dld = 1024; d.drow0 = 1024 + rt * 64; d.dk0 = kt * 64; }
    else if (kind == 1) {
        if (it < 1152) { const int rt = it / 24, kt = it % 24; const int br = rt >> 4, n0 = (rt & 15) * 64; d.dst = wb; d.dld = 1536; d.drow0 = br * 1024 + n0;
            if (kt < 16) { d.src = p.w_in + (size_t)l * D * PROJW; d.sld = PROJW; d.k0 = kt * 64; d.scol0 = 3584 + br * 1024 + n0; d.dk0 = kt * 64; }
            else { d.src = (br == 0 ? p.w_a : br == 1 ? p.w_b : p.w_c) + (size_t)l * 512 * 1024; d.sld = 1024; d.k0 = (kt - 16) * 64; d.scol0 = n0; d.dk0 = 1024 + (kt - 16) * 64; } }
        else { const int j = it - 1152; const int rt = j >> 4, kt = j & 15; d.src = p.w_out + (size_t)l * 1024 * 1024; d.sld = 1024; d.k0 = kt * 64; d.scol0 = rt * 64; d.dst = (bf16_t*)(ws + WS_WB + 9437184); d.dld = 1024; d.drow0 = rt * 64; d.dk0 = kt * 64; } }
    else if (kind == 2) { const int rt = it >> 4, kt = it & 15; const int drow0 = rt * 64; const int pn = drow0 >> 8, bj = (drow0 >> 7) & 1, i0 = drow0 & 127;
        d.src = p.w_up + (size_t)l * 1024 * 5632; d.sld = 5632; d.k0 = kt * 64; d.scol0 = bj * DFF + pn * 128 + i0; d.dst = (bf16_t*)(ws + WS_BIG + BIG_WUP); d.dld = 1024; d.drow0 = drow0; d.dk0 = kt * 64; }
    else { const int rt = it / 44, kt = it % 44; d.src = p.w_down + (size_t)l * DFF * 1024; d.sld = 1024; d.k0 = kt * 64; d.scol0 = rt * 64; d.dst = (bf16_t*)(ws + WS_BIG + BIG_WDOWN); d.dld = DFF; d.drow0 = rt * 64; d.dk0 = kt * 64; }
    return d;
}
__device__ __forceinline__ void conv_run(const Params& p, unsigned char* ws, int l, int kind, int ntiles, float* tl, int wgi, int nwg, int kwid) {
    const int tid = lv(TIDX);
    if (wgi < 0) return;
    for (int base = wgi * 4; base < ntiles; base += nwg * 4) {
#pragma unroll
        for (int q = 0; q < 4; ++q) { if (base + q < ntiles) { const ConvD d = conv_desc(p, ws, l, kind, base + q); float* t = tl + q * (64 * 65);
#pragma unroll
            for (int i = 0; i < 2; ++i) { const int kk = (tid >> 4) + 32 * i, c4 = (tid & 15) * 4;
                const f32x4 v = *(const f32x4*)(d.src + (size_t)(d.k0 + kk) * d.sld + d.scol0 + c4);
                t[kk * 65 + c4] = v[0]; t[kk * 65 + c4 + 1] = v[1]; t[kk * 65 + c4 + 2] = v[2]; t[kk * 65 + c4 + 3] = v[3]; } } }
        __syncthreads();
#pragma unroll
        for (int q = 0; q < 4; ++q) { if (base + q < ntiles) { const ConvD d = conv_desc(p, ws, l, kind, base + q); const float* t = tl + q * (64 * 65);
            const int r = tid >> 3, k8 = (tid & 7) * 8; float f[8];
#pragma unroll
            for (int j = 0; j < 8; ++j) f[j] = t[(k8 + j) * 65 + r];
            u32x4 w; w.x = cvt_pk_bf16(f[0], f[1]); w.y = cvt_pk_bf16(f[2], f[3]); w.z = cvt_pk_bf16(f[4], f[5]); w.w = cvt_pk_bf16(f[6], f[7]);
            *(u32x4*)(d.dst + (size_t)(d.drow0 + r) * d.dld + d.dk0 + k8) = w; } }
        __syncthreads();
    }
}
__device__ __forceinline__ void norm_phase(const float* hx, const float* hc, const float* g, const float* modl, int ish, int isc, bf16_t* abuf, int G, int nrows, int kwid) {
    const int tid_ = lv(TIDX); const int wave = tid_ >> 6, lane = tid_ & 63;
    for (int rowb = blockIdx.x * 8 + wave; rowb < nrows; rowb += G * 32) {
        f32x4 v[4][4]; int rows[4];
#pragma unroll
        for (int q = 0; q < 4; ++q) { const int r = rowb + q * G * 8; rows[q] = r; const int rc = r < nrows ? r : rowb;
            const float* src = (rc < MLAT) ? hx + (size_t)rc * 1024 : hc + (size_t)(rc - MLAT) * 1024;
#pragma unroll
            for (int i = 0; i < 4; ++i) v[q][i] = *(const f32x4*)(src + lane * 4 + 256 * i); }
#pragma unroll
        for (int q = 0; q < 4; ++q) { const int row = rows[q]; if (row < nrows) {
            const int brow = (row < MLAT) ? (row >> 11) : 16; const float* mp = modl + (size_t)brow * 6144;
            float ss = 0.f;
#pragma unroll
            for (int i = 0; i < 4; ++i) ss += v[q][i][0] * v[q][i][0] + v[q][i][1] * v[q][i][1] + v[q][i][2] * v[q][i][2] + v[q][i][3] * v[q][i][3];
            ss = wave_sum(ss, lane); const float rstd = rsqrtf(ss * (1.0f / 1024.0f) + 1e-6f);
#pragma unroll
            for (int i = 0; i < 4; ++i) { const int k = lane * 4 + 256 * i; const f32x4 gg = *(const f32x4*)(g + k), sh = *(const f32x4*)(mp + ish * 1024 + k), sc = *(const f32x4*)(mp + isc * 1024 + k);
                const f32x4 o = (v[q][i] * rstd * gg) * (sc + 1.0f) + sh; *(u32x2*)(abuf + (size_t)row * 1024 + k) = pack4(o); } } }
    }
}
__device__ __forceinline__ void final_norm(float* out, const float* g, int G, int kwid) {
    const int tid_ = lv(TIDX); const int wave = tid_ >> 6, lane = tid_ & 63;
    for (int rowb = blockIdx.x * 8 + wave; rowb < MLAT; rowb += G * 32) {
        f32x4 v[4][4];
#pragma unroll
        for (int q = 0; q < 4; ++q) { const int r = rowb + q * G * 8; const int rc = r < MLAT ? r : rowb;
#pragma unroll
            for (int i = 0; i < 4; ++i) v[q][i] = *(const f32x4*)(out + (size_t)rc * 1024 + lane * 4 + 256 * i); }
#pragma unroll
        for (int q = 0; q < 4; ++q) { const int row = rowb + q * G * 8; if (row < MLAT) { float ss = 0.f;
#pragma unroll
            for (int i = 0; i < 4; ++i) ss += v[q][i][0] * v[q][i][0] + v[q][i][1] * v[q][i][1] + v[q][i][2] * v[q][i][2] + v[q][i][3] * v[q][i][3];
            ss = wave_sum(ss, lane); const float rstd = rsqrtf(ss * (1.0f / 1024.0f) + 1e-6f);
#pragma unroll
            for (int i = 0; i < 4; ++i) { const int k = lane * 4 + 256 * i; const f32x4 gg = *(const f32x4*)(g + k); *(f32x4*)(out + (size_t)row * 1024 + k) = v[q][i] * rstd * gg; } } }
    }
}

__device__ __forceinline__ void fixup_phase(const bf16_t* hb, const float* cw, const float* cb, bf16_t* gated, int G, int nseg_all, int kwid) {
    const int total = nseg_all * 2 * (DFF / 4);
    for (int e = blockIdx.x * NTHR + lv(TIDX); e < total; e += G * NTHR) {
        const int j4 = (e % (DFF / 4)) * 4; const int sr = e / (DFF / 4); const int seg = sr >> 1, which = sr & 1;
        const bool lat = seg < 512; const int sl = lat ? (seg & 31) : ((seg - 512) & 3); const int nseg = lat ? 32 : 4;
        const bf16_t* pprev; const bf16_t* pcur; const bf16_t* pnext; bool zp = false, zn = false; int row;
        if (which == 0) { row = seg * 64; pcur = hb + (size_t)(seg * 4 + 0) * (2 * DFF); pnext = hb + (size_t)(seg * 4 + 1) * (2 * DFF); zp = (sl == 0); pprev = zp ? pcur : hb + (size_t)((seg - 1) * 4 + 3) * (2 * DFF); }
        else { row = seg * 64 + 63; pcur = hb + (size_t)(seg * 4 + 3) * (2 * DFF); pprev = hb + (size_t)(seg * 4 + 2) * (2 * DFF); zn = (sl == nseg - 1); pnext = zn ? pcur : hb + (size_t)((seg + 1) * 4 + 0) * (2 * DFF); }
        f32x4 uu[2];
#pragma unroll
        for (int hf = 0; hf < 2; ++hf) { const int cidx = hf * DFF + j4;
            f32x4 pv = unpack4(*(const u32x2*)(pprev + cidx)), cv = unpack4(*(const u32x2*)(pcur + cidx)), nv = unpack4(*(const u32x2*)(pnext + cidx));
            if (zp) pv = (f32x4){0.f, 0.f, 0.f, 0.f}; if (zn) nv = (f32x4){0.f, 0.f, 0.f, 0.f};
            uu[hf] = *(const f32x4*)(cw + cidx) * pv + *(const f32x4*)(cw + 2 * DFF + cidx) * cv + *(const f32x4*)(cw + 4 * DFF + cidx) * nv + *(const f32x4*)(cb + cidx); }
        f32x4 gg;
#pragma unroll
        for (int j = 0; j < 4; ++j) { const float a = uu[0][j]; gg[j] = a * __builtin_amdgcn_rcpf(1.0f + __expf(-a)) * uu[1][j]; }
        *(u32x2*)(gated + (size_t)row * DFF + j4) = pack4(gg);
    }
}

__device__ __forceinline__ void prep_a(const Params& p, unsigned char* ws, float* tl, int G, int kwid) {
    const int tid = lv(TIDX);
    float* modpart = (float*)(ws + WS_BIG + BIG_MODPART);
    for (int it = blockIdx.x; it < 4 * 24 * 8; it += G) { const int kc = it & 7, nc = (it >> 3) % 24, l = it / 192;
        __syncthreads();
        for (int e = tid; e < 17 * 128; e += NTHR) { const int r = e >> 7, k = e & 127; const float v = (r < 16) ? p.c[r * 1024 + kc * 128 + k] : p.c_ctx[kc * 128 + k]; tl[e] = v / (1.0f + __expf(-v)); }
        __syncthreads();
        const int col = nc * 256 + (tid & 255), kh = tid >> 8; float acc[17];
#pragma unroll
        for (int r = 0; r < 17; ++r) acc[r] = 0.f;
        const float* wp = p.w_ada + (size_t)l * 1024 * 6144 + (size_t)(kc * 128 + kh * 64) * 6144 + col;
        for (int k = 0; k < 64; ++k) { const float w = wp[(size_t)k * 6144];
#pragma unroll
            for (int r = 0; r < 17; ++r) acc[r] += tl[r * 128 + kh * 64 + k] * w; }
        float* xs = tl + 17 * 128;
        if (kh == 1) {
#pragma unroll
            for (int r = 0; r < 17; ++r) xs[r * 256 + (tid & 255)] = acc[r]; }
        __syncthreads();
        if (kh == 0) {
#pragma unroll
            for (int r = 0; r < 17; ++r) modpart[((size_t)(kc * 4 + l) * 17 + r) * 6144 + col] = acc[r] + xs[r * 256 + (tid & 255)]; }
    }
    { float* rope = (float*)(ws + WS_ROPE);
      for (int e = blockIdx.x * NTHR + tid; e < 1024; e += G * NTHR) { const int pos = e >> 4, f = e & 15; const float inv = powf(10000.0f, -(float)f / 16.0f); const float ang = (float)pos * inv; rope[e] = cosf(ang); rope[1024 + e] = sinf(ang); } }
    if (blockIdx.x == 0 && tid < 64) { float* lamv = (float*)(ws + WS_LAM);
        for (int l = 0; l < 4; ++l) { const float* lv = p.lam + l * 256; const int lane = tid & 63; const float s1 = wave_sum(lv[tid] * lv[64 + tid], lane), s2 = wave_sum(lv[128 + tid] * lv[192 + tid], lane);
            if (tid == 0) lamv[l] = expf(s1) - expf(s2) + (0.8f - 0.6f * expf(-0.3f * (float)l)); } }
    __syncthreads();
    for (int e = tid; e < 2048; e += NTHR) tl[e] = cospif((float)e / 1024.0f);
    __syncthreads();
    { bf16_t* dm = (bf16_t*)(ws + WS_DMAT);
      for (int e = blockIdx.x * NTHR + tid; e < 2048 * 512; e += G * NTHR) { const int n = e >> 9, k8 = (e & 511) * 8; float f[8];
#pragma unroll
          for (int j = 0; j < 8; ++j) { const int kp = k8 + j; const int k = (kp & ~31) | (((kp >> 2) & 1) << 4) | (((kp >> 3) & 3) << 2) | (kp & 3); f[j] = (k < 2048) ? tl[(n * k) & 2047] : -tl[(n * (k - 2048) + 1536) & 2047]; }
          u32x4 w; w.x = cvt_pk_bf16(f[0], f[1]); w.y = cvt_pk_bf16(f[2], f[3]); w.z = cvt_pk_bf16(f[4], f[5]); w.w = cvt_pk_bf16(f[6], f[7]);
          *(u32x4*)(dm + (size_t)n * 4096 + k8) = w; }
      bf16_t* dc = (bf16_t*)(ws + WS_DC);
      for (int e = blockIdx.x * NTHR + tid; e < 256 * 64; e += G * NTHR) { const int n = e >> 6, k8 = (e & 63) * 8; float f[8];
#pragma unroll
          for (int j = 0; j < 8; ++j) { const int kp = k8 + j; const int k = (kp & ~31) | (((kp >> 2) & 1) << 4) | (((kp >> 3) & 3) << 2) | (kp & 3); f[j] = (k < 256) ? tl[((n * k) & 255) * 8] : -tl[(((n * (k - 256)) & 255) * 8 + 1536) & 2047]; }
          u32x4 w; w.x = cvt_pk_bf16(f[0], f[1]); w.y = cvt_pk_bf16(f[2], f[3]); w.z = cvt_pk_bf16(f[4], f[5]); w.w = cvt_pk_bf16(f[6], f[7]);
          *(u32x4*)(dc + (size_t)n * 512 + k8) = w; } }
}
__device__ __forceinline__ void prep_b(const Params& p, unsigned char* ws, int G, int kwid) {
    const float* modpart = (const float*)(ws + WS_BIG + BIG_MODPART); float* mod = (float*)(ws + WS_MOD);
    for (int e = blockIdx.x * NTHR + lv(TIDX); e < 4 * 17 * 6144; e += G * NTHR) { const int n = e % 6144, l = e / (17 * 6144); float s = p.b_ada[l * 6144 + n];
#pragma unroll
        for (int kc = 0; kc < 8; ++kc) s += modpart[(size_t)kc * (4 * 17 * 6144) + e];
        mod[e] = s; }
}

#define MFMA16(a, b, c) __builtin_amdgcn_mfma_f32_16x16x32_bf16(a, b, c, 0, 0, 0)
constexpr float LOG2E = 1.4426950408889634f;
__device__ __forceinline__ bf16x8 mk8(u32x2 a, u32x2 b) { u32x4 w; w.x = a.x; w.y = a.y; w.z = b.x; w.w = b.y; return __builtin_bit_cast(bf16x8, w); }

__device__ __forceinline__ void diffattn_item(LAS unsigned char* lds, const bf16_t* proj, const bf16_t* vtb, bf16_t* brb, const float* subg, float lam, int post,
                              int b, int h, int qtok0, int kt0, int kt1, int kwid) {
    const int tid = lv(TIDX), wid = __builtin_amdgcn_readfirstlane(tid >> 6), lane = tid & 63, fr = lane & 15, fq = lane >> 4;
    const int sub = wid >> 2, qrow0 = qtok0 + (wid & 3) * 32;
    bf16x8 qf[2][2];
#pragma unroll
    for (int qt = 0; qt < 2; ++qt)
#pragma unroll
        for (int dh = 0; dh < 2; ++dh) qf[qt][dh] = *(const bf16x8*)(proj + (size_t)(qrow0 + qt * 16 + fr) * 2048 + h * 128 + sub * 64 + dh * 32 + fq * 8);
    f32x4 O[8][2];
#pragma unroll
    for (int et = 0; et < 8; ++et) { O[et][0] = (f32x4){0.f, 0.f, 0.f, 0.f}; O[et][1] = (f32x4){0.f, 0.f, 0.f, 0.f}; }
    float mrun[2] = {-1e30f, -1e30f}, lrun[2] = {0.f, 0.f};
    u32x4 kreg[4], vreg[4];
    const unsigned koff0 = (unsigned)((tid >> 4) * 2048 + (tid & 15) * 8) * 2u, voff0 = (unsigned)((tid >> 4) * 2304 + (tid & 15) * 8) * 2u;
#define DA_GLOAD(kt) do { const int _kr = (kt) < 16 ? b * 2048 + (kt) * 128 : MLAT + b * 256 + ((kt) - 16) * 128; \
        const char* _kb = (const char*)(proj + (size_t)_kr * 2048 + 512 + h * 128); const char* _vb = (const char*)(vtb + (size_t)(b * 512 + h * 128) * 2304 + (kt) * 128); \
        _Pragma("unroll") for (int _i = 0; _i < 4; ++_i) { \
        kreg[_i] = *(const u32x4*)(_kb + (size_t)_i * (32 * 2048 * 2) + (size_t)koff0); \
        vreg[_i] = *(const u32x4*)(_vb + (size_t)_i * (32 * 2304 * 2) + (size_t)voff0); } } while (0)
#define DA_LWRITE(kb) do { _Pragma("unroll") for (int _i = 0; _i < 4; ++_i) { const int ch = tid + 512 * _i; \
        *(LAS u32x4*)(lds + (kb) * 34816 + (ch >> 4) * 272 + (ch & 15) * 16) = kreg[_i]; \
        *(LAS u32x4*)(lds + 69632 + (kb) * 34816 + (ch >> 4) * 272 + (ch & 15) * 16) = vreg[_i]; } } while (0)
    __syncthreads();
    DA_GLOAD(kt0); DA_LWRITE(0); __syncthreads();
    for (int kt = kt0; kt < kt1; ++kt) {
        const int cur = (kt - kt0) & 1;
        if (kt + 1 < kt1) DA_GLOAD(kt + 1);
#pragma unroll
        for (int hk = 0; hk < 2; ++hk) {
        f32x4 S[4][2];
#pragma unroll
        for (int kq = 0; kq < 4; ++kq) { S[kq][0] = (f32x4){0.f, 0.f, 0.f, 0.f}; S[kq][1] = (f32x4){0.f, 0.f, 0.f, 0.f}; }
#pragma unroll
        for (int kq = 0; kq < 4; ++kq)
#pragma unroll
            for (int dh = 0; dh < 2; ++dh) { const bf16x8 kf = *(const LAS bf16x8*)(lds + cur * 34816 + (hk * 64 + kq * 16 + fr) * 272 + (sub * 64 + dh * 32 + fq * 8) * 2);
                S[kq][0] = MFMA16(kf, qf[0][dh], S[kq][0]); S[kq][1] = MFMA16(kf, qf[1][dh], S[kq][1]); }
        bf16x8 pb[2][2];
#pragma unroll
        for (int qt = 0; qt < 2; ++qt) {
            float mx = -1e30f;
#pragma unroll
            for (int kq = 0; kq < 4; ++kq)
#pragma unroll
                for (int j = 0; j < 4; ++j) mx = fmaxf(mx, S[kq][qt][j]);
            mx = fmaxf(mx, SHX(mx, 16)); mx = fmaxf(mx, SHX(mx, 32));
            const float mxs = mx * LOG2E; const float mnew = (mxs > mrun[qt] + 8.0f) ? mxs : mrun[qt]; const float alpha = __builtin_amdgcn_exp2f(mrun[qt] - mnew); mrun[qt] = mnew;
            f32x4 lsv = (f32x4){0.f, 0.f, 0.f, 0.f}; u32x2 pk[4];
#pragma unroll
            for (int kq = 0; kq < 4; ++kq) { const f32x4 t = S[kq][qt] * LOG2E - mnew; f32x4 pv;
#pragma unroll
                for (int j = 0; j < 4; ++j) pv[j] = __builtin_amdgcn_exp2f(t[j]);
                lsv += pv; pk[kq] = pack4(pv); }
            lrun[qt] = lrun[qt] * alpha + ((lsv[0] + lsv[1]) + (lsv[2] + lsv[3]));
            if (__builtin_amdgcn_ballot_w64(alpha != 1.0f) != 0ull) {
#pragma unroll
                for (int et = 0; et < 8; ++et) O[et][qt] *= alpha; }
            pb[qt][0] = mk8(pk[0], pk[1]); pb[qt][1] = mk8(pk[2], pk[3]);
        }
#pragma unroll
        for (int kc2 = 0; kc2 < 2; ++kc2)
#pragma unroll
            for (int et = 0; et < 8; ++et) { const bf16x8 vf = *(const LAS bf16x8*)(lds + 69632 + cur * 34816 + (et * 16 + fr) * 272 + (hk * 64 + kc2 * 32 + fq * 8) * 2);
                O[et][0] = MFMA16(vf, pb[0][kc2], O[et][0]); O[et][1] = MFMA16(vf, pb[1][kc2], O[et][1]); }
        }
        if (kt + 1 < kt1) DA_LWRITE(cur ^ 1);
        __syncthreads();
    }
#undef DA_GLOAD
#undef DA_LWRITE
#pragma unroll
    for (int qt = 0; qt < 2; ++qt) { float l = lrun[qt]; l += SHX(l, 16); l += SHX(l, 32); const float inv = 1.0f / l;
#pragma unroll
        for (int et = 0; et < 8; ++et) O[et][qt] *= inv; }
    if (sub == 1) {
#pragma unroll
        for (int qt = 0; qt < 2; ++qt)
#pragma unroll
            for (int et = 0; et < 8; ++et) *(LAS f32x4*)(lds + ((wid & 3) * 16 + qt * 8 + et) * 1024 + lane * 16) = O[et][qt]; }
    __syncthreads();
    if (sub == 0) {
#pragma unroll
        for (int qt = 0; qt < 2; ++qt) { float ss = 0.f;
#pragma unroll
            for (int et = 0; et < 8; ++et) { const f32x4 x1 = *(const LAS f32x4*)(lds + ((wid & 3) * 16 + qt * 8 + et) * 1024 + lane * 16); const f32x4 o = O[et][qt] - x1 * lam; O[et][qt] = o;
                ss += o[0] * o[0] + o[1] * o[1] + o[2] * o[2] + o[3] * o[3]; }
            ss += SHX(ss, 16); ss += SHX(ss, 32);
            const int li_ = post; const int pbits_ = lsg(li_ == 0 ? (int)0x3f4ccccdu : li_ == 1 ? (int)0x3f24fd5cu : li_ == 2 ? (int)0x3f077f5au : (int)0x3ee34c57u); const float postf = __int_as_float(pbits_);
            const float rstd = rsqrtf(ss * (1.0f / 128.0f) + 1e-5f) * postf;
            bf16_t* rp = brb + (size_t)(qrow0 + qt * 16 + fr) * 1536 + 512 + h * 128 + fq * 4;
#pragma unroll
            for (int et = 0; et < 8; ++et) { const f32x4 g = *(const f32x4*)(subg + et * 16 + fq * 4); *(u32x2*)(rp + et * 16) = pack4(O[et][qt] * rstd * g); } } }
    __syncthreads();
}

__device__ __forceinline__ void na_chunk(const LAS unsigned char* kb, const LAS unsigned char* vb, int vstride, int kbase, const bf16x8 (&qf)[2], f32x4 (&O)[4], float& mrun, float& lrun,
                                         int fr, int fq, bool usebias, const LAS float* rpbs, int rowidx0, const int (&dcoff)[8]) {
    const int lane = fq * 16 + fr;
    f32x4 S[4];
#pragma unroll
    for (int kq = 0; kq < 4; ++kq) { S[kq] = (f32x4){0.f, 0.f, 0.f, 0.f};
#pragma unroll
        for (int dh = 0; dh < 2; ++dh) { const bf16x8 kf = *(const LAS bf16x8*)(kb + (kbase + kq * 16 + fr) * 144 + (dh * 32 + fq * 8) * 2); S[kq] = MFMA16(kf, qf[dh], S[kq]); } }
    if (usebias) {
#pragma unroll
        for (int kq = 0; kq < 4; ++kq)
#pragma unroll
            for (int j = 0; j < 4; ++j) { const int dco = dcoff[(kq & 1) * 4 + j];
                const float bv = *(const LAS float*)((const LAS unsigned char*)rpbs + (rowidx0 + (kq >> 1)) * 124 + (dco < 0 ? 0 : dco)); S[kq][j] = dco >= 0 ? S[kq][j] + bv : -1e30f; } }
    float mx = -1e30f;
#pragma unroll
    for (int kq = 0; kq < 4; ++kq)
#pragma unroll
        for (int j = 0; j < 4; ++j) mx = fmaxf(mx, S[kq][j]);
    mx = fmaxf(mx, SHX(mx, 16)); mx = fmaxf(mx, SHX(mx, 32));
    const float mnew = fmaxf(mrun, mx * LOG2E); const float alpha = __builtin_amdgcn_exp2f(mrun - mnew); mrun = mnew;
    f32x4 lsv = (f32x4){0.f, 0.f, 0.f, 0.f}; u32x2 pk[4];
#pragma unroll
    for (int kq = 0; kq < 4; ++kq) { const f32x4 t = S[kq] * LOG2E - mnew; f32x4 pv;
#pragma unroll
        for (int j = 0; j < 4; ++j) pv[j] = __builtin_amdgcn_exp2f(t[j]);
        lsv += pv; pk[kq] = pack4(pv); }
    lrun = lrun * alpha + ((lsv[0] + lsv[1]) + (lsv[2] + lsv[3]));
    const bf16x8 pb0 = mk8(pk[0], pk[1]), pb1 = mk8(pk[2], pk[3]);
#pragma unroll
    for (int et = 0; et < 4; ++et) { O[et] *= alpha;
        const LAS unsigned char* vp = vb + (et * 16 + fr) * vstride + (kbase + fq * 4) * 2;
        O[et] = MFMA16(mk8(*(const LAS u32x2*)vp, *(const LAS u32x2*)(vp + 32)), pb0, O[et]);
        O[et] = MFMA16(mk8(*(const LAS u32x2*)(vp + 64), *(const LAS u32x2*)(vp + 96)), pb1, O[et]); }
}

__device__ __forceinline__ void na_item(LAS unsigned char* lds, const bf16_t* proj, const bf16_t* vtc, const float* rpbh, bf16_t* brb, int b, int h, int mode, int jblk, int band, int kwid) {
    const int tid = lv(TIDX), wid = __builtin_amdgcn_readfirstlane(tid >> 6), lane = tid & 63, fr = lane & 15, fq = lane >> 4;
    const int qtok = (mode == 0) ? b * 2048 + (band * 8 + wid) * 64 + jblk * 16 + fr : MLAT + b * 256 + band * 128 + wid * 16 + fr;
    bf16x8 qf[2];
#pragma unroll
    for (int dh = 0; dh < 2; ++dh) qf[dh] = *(const bf16x8*)(proj + (size_t)qtok * 2048 + 1024 + h * 64 + dh * 32 + fq * 8);
    f32x4 O[4];
#pragma unroll
    for (int et = 0; et < 4; ++et) O[et] = (f32x4){0.f, 0.f, 0.f, 0.f};
    float mrun = -1e30f, lrun = 0.f;
    LAS float* rpbs = (LAS float*)(lds + 133120);
    __syncthreads();
#pragma unroll
    for (int i = 0; i < 4; ++i) { const int ch = tid + 512 * i; const int key = ch >> 3, c16 = ch & 7;
        *(LAS u32x4*)(lds + key * 144 + c16 * 16) = *(const u32x4*)(proj + (size_t)(MLAT + b * 256 + key) * 2048 + 1536 + h * 64 + c16 * 8);
        const int e = ch >> 5, d16 = ch & 31;
        *(LAS u32x4*)(lds + 36864 + e * 528 + d16 * 16) = *(const u32x4*)(vtc + (size_t)(b * 512 + h * 64 + e) * 2304 + 2048 + d16 * 8); }
    if (mode == 0) for (int e = tid; e < 465; e += NTHR) rpbs[e] = rpbh[e];
    const int rfirst = band * 8; const int R0 = min(max(rfirst - 4, 0), 24), nrows = min(max(rfirst + 7 - 4, 0), 24) + 8 - R0; const int kc0 = min(max(16 * jblk - 8, 0), 32);
    const int per_e = nrows * 4;
    int dcoff[8];
    { const int qcol_ = jblk * 16 + fr; const int c0_ = min(max(qcol_ - 8, 0), 48);
#pragma unroll
      for (int t = 0; t < 8; ++t) { const int kcol = kc0 + (t >> 2) * 16 + fq * 4 + (t & 3); const bool ok = (kcol >= c0_) && (kcol < c0_ + 16); const int dc = min(max(kcol - qcol_ + 15, 0), 30); dcoff[t] = ok ? dc * 4 : -1; } }
    u32x4 kl[8], vl[8];
    if (mode == 0) {
#pragma unroll
        for (int i = 0; i < 8; ++i) { const int ch = tid + 512 * i;
            if (ch < nrows * 256) { const int key = ch >> 3, c16 = ch & 7; const int il = key >> 5, w = key & 31;
                kl[i] = *(const u32x4*)(proj + (size_t)(b * 2048 + (R0 + il) * 64 + kc0 + w) * 2048 + 1536 + h * 64 + c16 * 8); }
            if (ch < 64 * per_e) { const int e = ch / per_e, rem = ch - e * per_e; const int il = rem >> 2, c16 = rem & 3;
                vl[i] = *(const u32x4*)(vtc + (size_t)(b * 512 + h * 64 + e) * 2304 + (R0 + il) * 64 + kc0 + c16 * 8); } }
    }
    __syncthreads();
#pragma unroll 1
    for (int c = 0; c < 4; ++c) na_chunk(lds, lds + 36864, 528, c * 64, qf, O, mrun, lrun, fr, fq, false, rpbs, 0, dcoff);
    if (mode == 0) {
        __syncthreads();
#pragma unroll
        for (int i = 0; i < 8; ++i) { const int ch = tid + 512 * i;
            if (ch < nrows * 256) { const int key = ch >> 3, c16 = ch & 7; *(LAS u32x4*)(lds + key * 144 + c16 * 16) = kl[i]; }
            if (ch < 64 * per_e) { const int e = ch / per_e, rem = ch - e * per_e; const int il = rem >> 2, c16 = rem & 3; *(LAS u32x4*)(lds + 69120 + e * 976 + (il * 32 + c16 * 8) * 2) = vl[i]; } }
        __syncthreads();
        const int r = band * 8 + wid; const int r0 = min(max(r - 4, 0), 24); const int ilb = r0 - R0; const int qcol = jblk * 16 + fr;
#pragma unroll 1
        for (int c = 0; c < 4; ++c) na_chunk(lds, lds + 69120, 976, (ilb + 2 * c) * 32, qf, O, mrun, lrun, fr, fq, true, rpbs, r0 + 2 * c - r + 7, dcoff);
    }
    float l = lrun; l += SHX(l, 16); l += SHX(l, 32); const float inv = 1.0f / l;
    bf16_t* rp = brb + (size_t)qtok * 1536 + 1024 + h * 64 + fq * 4;
#pragma unroll
    for (int et = 0; et < 4; ++et) *(u32x2*)(rp + et * 16) = pack4(O[et] * inv);
    __syncthreads();
}


#define XB_TMO      128
#define XB_XCNT(j)  (256  + 64 * (j))
#define XB_XSUB(j)  (1280 + 64 * (j))
#define XB_XGEN(j)  (2304 + 64 * (j))
#define XB_TOP      3328
#define XB_TOPGEN   3392
#define XCD_BAR_WORDS 3456
#define XB_SPIN_CAP (1u << 22)
__device__ __forceinline__ unsigned xb_ld(unsigned* p)              { return __hip_atomic_load(p, __ATOMIC_RELAXED, __HIP_MEMORY_SCOPE_AGENT); }
__device__ __forceinline__ unsigned xb_add(unsigned* p, unsigned v) { return __hip_atomic_fetch_add(p, v, __ATOMIC_RELAXED, __HIP_MEMORY_SCOPE_AGENT); }
__device__ __forceinline__ unsigned xb_xcc_id() { return (unsigned)__builtin_amdgcn_s_getreg((3 << 11) | 20) & 0xFu; }
#define XB_SPIN(cond, bar) do { unsigned _sp = 0; while (cond) { __builtin_amdgcn_s_sleep(1); \
    if ((++_sp & 255u) == 0u) { if (xb_ld(&(bar)[XB_TMO])) break; if (_sp > XB_SPIN_CAP) { atomicAdd(&(bar)[XB_TMO], 1u); break; } } } } while (0)
__device__ __forceinline__ void xcd_barrier_complete(unsigned* bar, unsigned x, unsigned G, unsigned& nloc, unsigned& nx) {
    unsigned sum, cnt, mine, sp = 0u;
    for (;;) {
        sum = 0u; cnt = 0u; mine = 0u;
#pragma unroll
        for (unsigned j = 0; j < 16; ++j) { const unsigned c = xb_ld(&bar[XB_XCNT(j)]); sum += c; cnt += (c > 0u) ? 1u : 0u; mine = (j == x) ? c : mine; }
        if (sum == G) break;
        __builtin_amdgcn_s_sleep(1);
        if ((++sp & 255u) == 0u) { if (xb_ld(&bar[XB_TMO])) break; if (sp > XB_SPIN_CAP) { atomicAdd(&bar[XB_TMO], 1u); break; } }
    }
    nloc = mine > 0u ? mine : 1u; nx = cnt > 0u ? cnt : 1u;
}
__device__ __forceinline__ void xcd_barrier(unsigned* bar, volatile LAS unsigned* st, unsigned G, int kwid) {
    asm volatile("s_waitcnt vmcnt(0)" ::: "memory");
    __syncthreads();
    if (TIDX == 0) {
        __builtin_amdgcn_s_waitcnt(0);
        const unsigned x = xb_xcc_id();
        unsigned nloc = st[0], nx = st[1];
        if (nloc == 0u) { xcd_barrier_complete(bar, x, G, nloc, nx); st[0] = nloc; st[1] = nx; }
        const unsigned old = xb_add(&bar[XB_XSUB(x)], 1u);
        const unsigned gen = old / nloc;
        if (old + 1u == (gen + 1u) * nloc) {
            __builtin_amdgcn_fence(__ATOMIC_RELEASE, "agent");
            asm volatile("s_waitcnt vmcnt(0)" ::: "memory");
            const unsigned og = xb_add(&bar[XB_TOP], 1u);
            const unsigned tg = og / nx;
            if (og + 1u == (tg + 1u) * nx) xb_add(&bar[XB_TOPGEN], 1u);
            else XB_SPIN(xb_ld(&bar[XB_TOPGEN]) == tg, bar);
            __builtin_amdgcn_fence(__ATOMIC_ACQUIRE, "agent");
            xb_add(&bar[XB_XGEN(x)], 1u);
            asm volatile("s_waitcnt vmcnt(0)" ::: "memory");
        } else {
            XB_SPIN(xb_ld(&bar[XB_XGEN(x)]) == gen, bar);
            __builtin_amdgcn_fence(__ATOMIC_ACQUIRE, "agent");
            asm volatile("s_waitcnt vmcnt(0)" ::: "memory");
        }
    }
    __syncthreads();
}

#ifdef REPEAT_S
constexpr int NPHASE = 2 + 10 * DEPTH + 1;
#else
constexpr int NPHASE = 2 + 8 * DEPTH + 1;
#endif
#ifndef EN
#define EN 0xFFFF
#endif
#define ON(k) ((EN >> (k)) & 1)
__global__ void __launch_bounds__(NTHR) mega(Params p_in, int ph_lo, int ph_hi) {
    extern __shared__ __attribute__((aligned(16))) unsigned char smem[];
    LAS unsigned char* lds = (LAS unsigned char*)smem;
    float* tl = (float*)smem;
    const int kwid = __builtin_amdgcn_readfirstlane((int)threadIdx.x >> 6);
    cg::grid_group grid = cg::this_grid();
    volatile LAS unsigned* xst = (volatile LAS unsigned*)(lds + LDS_BYTES - 16);
    { unsigned* bar0 = (unsigned*)(p_in.ws + WS_BAR); if (TIDX == 0) { xst[0] = 0u; xst[1] = 0u; (void)xb_add(&bar0[XB_XCNT(xb_xcc_id())], 1u); } __syncthreads(); }
    for (int ph = ph_lo; ph < ph_hi; ++ph) {
        const int G = lsg((int)gridDim.x), c = lsg((int)blockIdx.x);
        const Params& p = p_in; unsigned char* ws = lptr(p_in.ws); float* outp = lptr(p_in.out);
        const float* mod = (const float*)(ws + WS_MOD);
        bf16_t* abuf = (bf16_t*)(ws + WS_ABUF); bf16_t* brb = (bf16_t*)(ws + WS_BR);
        float* hc = (float*)(ws + WS_HC);
        unsigned char* big = ws + WS_BIG;
        if (ph == 0) { if (ON(0)) prep_a(p, ws, tl, G, kwid); }
        else if (ph == 1) { if (ON(0)) prep_b(p, ws, G, kwid); }
        else if (ph == NPHASE - 1) final_norm(outp, p.g_final, G, kwid);
        else {
#ifdef REPEAT_S
            const int l = (ph - 2) / 10, s_ = (ph - 2) % 10; const int s = (s_ <= REPEAT_S) ? s_ : s_ - 1;
#define PROBE_NOSTORE ((s_ == REPEAT_S + 1) ? 1 : 0)
#else
            const int l = (ph - 2) / 8, s_raw = (ph - 2) % 8; const int s = s_raw < 4 ? s_raw : s_raw + 1;
#define PROBE_NOSTORE 0
#endif
            const float* modl = mod + (size_t)l * 17 * 6144;
            const bool lastl = (l == DEPTH - 1); const int nMl = lastl ? 128 : 144;
            const float* hx_in = (l == 0) ? p.x : outp; const float* hc_in = (l == 0) ? p.ctx : hc;
            const int swg = lastl ? c : c - 64, snw = lastl ? G : G - 64;
            if (s == 0) { if (l == 0) { conv_run(p, ws, l, 0, 768, tl, c, G, kwid); conv_win_fold(p, ws, l, tl, c, G, kwid); } norm_phase(hx_in, hc_in, p.g_mix + l * 1024, modl, 0, 1, abuf, G, MTOT, kwid); }
            else if (s == 1) { PolInProj pol{(const char*)abuf, (const char*)(ws + WS_WB), (bf16_t*)(big + BIG_PROJ), (bf16_t*)(big + BIG_T), (bf16_t*)(big + BIG_TC), (bf16_t*)(big + BIG_VTB), (bf16_t*)(big + BIG_VTC), lds + 131072, G, c, PROBE_NOSTORE};
                { const int t_ = lv(TIDX); const float* rope = (const float*)(ws + WS_ROPE); for (int e = t_; e < 2048; e += NTHR) *(LAS float*)(lds + 131072 + e * 4) = rope[e]; __syncthreads(); }
                gemm_run(lds, pol, kwid); }
            else if (s == 2) {
                conv_run(p, ws, l, 1, 1408, tl, c, G, kwid);
                { PolDft pol{(const char*)(ws + WS_DMAT), (const char*)(ws + WS_DC), (const char*)(big + BIG_T), (const char*)(big + BIG_TC), brb, G, c, lastl ? 256 : 288}; gemm_run(lds, pol, kwid); }
                const bf16_t* proj = (const bf16_t*)(big + BIG_PROJ);
                const float lam = __int_as_float(__builtin_amdgcn_readfirstlane(__float_as_int(((const float*)(ws + WS_LAM))[l]))); const int post = l;
                for (long L = c; L < (lastl ? 1024 : 1024 + 128); L += G) {
                    int b_, h_, q0_, k0_;
                    if (L < 1024) { const int rr = (int)L >> 8, cc = (int)L & 255; const int pair = rr * 16 + (cc & 7) * 2 + (cc >> 7), qb = (cc >> 3) & 15; b_ = pair >> 2; h_ = pair & 3; q0_ = b_ * 2048 + qb * 128; k0_ = 0; }
                    else { const int j = (int)L - 1024; b_ = j >> 3; h_ = (j >> 1) & 3; q0_ = MLAT + b_ * 256 + (j & 1) * 128; k0_ = 16; }
                    diffattn_item(lds, proj, (const bf16_t*)(big + BIG_VTB), brb, p.subln_g + l * 128, lam, post, b_, h_, q0_, k0_, 18, kwid); }
                for (long L = c; L < (lastl ? 2048 : 2048 + 256); L += G) {
                    int b_, h_, mode_, j_, band_;
                    if (L < 2048) { const int rr = (int)L >> 8, cc = (int)L & 255; const int pair = rr * 16 + (cc & 7) * 2 + (cc >> 7), sub = (cc >> 3) & 15; b_ = pair >> 3; h_ = pair & 7; mode_ = 0; j_ = sub & 3; band_ = sub >> 2; }
                    else { const int j = (int)L - 2048; b_ = j >> 4; h_ = (j >> 1) & 7; mode_ = 1; j_ = 0; band_ = j & 1; }
                    na_item(lds, proj, (const bf16_t*)(big + BIG_VTC), p.rpb + (size_t)(l * 8 + h_) * 465, brb, b_, h_, mode_, j_, band_, kwid); }
            }
            else if (s == 3) { PolMW pol{(const char*)abuf, (const char*)brb, (const char*)(ws + WS_WB), p.b_gate + l * 3072, (u32x4*)(big + BIG_GSCR), (f32x4*)(big + BIG_SSCR), (bf16_t*)(big + BIG_MERGED),
                    (const char*)(ws + WS_WB + 9437184), hx_in, outp, hc_in, hc, modl, (unsigned*)(ws + WS_BAR + 14336), 32u * (unsigned)(l + 1), G, c, nMl};
                gemm_run(lds, pol, kwid);
                conv_run(p, ws, l, 2, 1408, tl, swg, snw, kwid); conv_run(p, ws, l, 3, 704, tl, swg, snw, kwid); }
            else if (s == 5) { norm_phase(outp, hc, p.g_ffn + l * 1024, modl, 3, 4, abuf, G, lastl ? MLAT : MTOT, kwid); }
            else if (s == 6) { PolUp pol{(const char*)abuf, (const char*)(big + BIG_WUP), p.conv_w + (size_t)l * 3 * 5632, p.conv_b + (size_t)l * 5632, (bf16_t*)(big + BIG_GATED), (bf16_t*)(big + BIG_HB), G, c, nMl, lds + 131072}; gemm_run(lds, pol, kwid); }
            else if (s == 7) { fixup_phase((const bf16_t*)(big + BIG_HB), p.conv_w + (size_t)l * 3 * 5632, p.conv_b + (size_t)l * 5632, (bf16_t*)(big + BIG_GATED), G, lastl ? 512 : 576, kwid); }
            else { PolResid pol{(const char*)(big + BIG_GATED), 5632, (const char*)(big + BIG_WDOWN), 5632, 44, outp, outp, hc, hc, modl, 5, G, c, nMl}; gemm_run(lds, pol, kwid);
                if (!lastl) { conv_run(p, ws, l + 1, 0, 768, tl, swg, snw, kwid); conv_win_fold(p, ws, l + 1, tl, swg, snw, kwid); } }
        }
        if (ph + 1 < ph_hi) {
            if (ph_lo < 0) { __threadfence(); grid.sync(); }
            xcd_barrier((unsigned*)(ws + WS_BAR), xst, (unsigned)G, kwid);
        }
    }
}

extern "C" void kernel_launch(void* const* d_in, const int* in_sizes, int n_in, void* d_out, int out_size, void* d_ws, size_t ws_size, hipStream_t stream) {
    static int grid_blocks = 0;
    if (grid_blocks == 0) {
        if (n_in != 22 || ws_size < WS_END) { fprintf(stderr, "kernel_launch: unexpected n_in %d or ws_size %zu (need %zu)\n", n_in, ws_size, (size_t)WS_END); grid_blocks = -1; return; }
        if (hipFuncSetAttribute((const void*)mega, hipFuncAttributeMaxDynamicSharedMemorySize, LDS_BYTES) != hipSuccess) { fprintf(stderr, "hipFuncSetAttribute failed\n"); grid_blocks = -1; return; }
        int dev = 0, cus = 0, per_cu = 0;
        hipGetDevice(&dev); hipDeviceGetAttribute(&cus, hipDeviceAttributeMultiprocessorCount, dev);
        hipOccupancyMaxActiveBlocksPerMultiprocessor(&per_cu, (const void*)mega, NTHR, LDS_BYTES);
        if (per_cu < 1) { fprintf(stderr, "occupancy query says %d blocks/CU\n", per_cu); per_cu = 1; }
        (void)hipGetLastError();
        grid_blocks = cus;
    }
    if (grid_blocks < 0) return;
    if (hipMemsetAsync((char*)d_ws + WS_BAR, 0, 16384, stream) != hipSuccess) { fprintf(stderr, "memset failed\n"); return; }
    Params p{};
    const float** pp = (const float**)&p;
    for (int i = 0; i < 22; ++i) pp[i] = (const float*)d_in[i];
    p.out = (float*)d_out; p.ws = (unsigned char*)d_ws;
    int lo = 0, hi = NPHASE;
    void* args[] = {&p, &lo, &hi};
    hipError_t e = hipLaunchCooperativeKernel((const void*)mega, dim3(grid_blocks), dim3(NTHR), args, LDS_BYTES, stream);
    if (e != hipSuccess) fprintf(stderr, "cooperative launch failed: %s (grid %d)\n", hipGetErrorString(e), grid_blocks);
}
```

```cpp
#include <hip/hip_runtime.h>
#include <hip/hip_cooperative_groups.h>
#include <cstdio>
namespace cg = cooperative_groups;

#define LAS __attribute__((address_space(3)))
__device__ __forceinline__ int mytid_(int kwid) { int z = 0; asm volatile("" : "+v"(z)); return kwid * 64 + (int)__builtin_amdgcn_mbcnt_hi(~0u, __builtin_amdgcn_mbcnt_lo(~0u, (unsigned)z)); }
#define TIDX mytid_(kwid)
typedef unsigned short bf16_t;
typedef short bf16x8 __attribute__((ext_vector_type(8)));
typedef float f32x4 __attribute__((ext_vector_type(4)));
typedef unsigned u32x4 __attribute__((ext_vector_type(4)));
typedef unsigned u32x2 __attribute__((ext_vector_type(2)));

constexpr int D = 1024, NB = 16, SEQ = 2048, CTXL = 256, DEPTH = 4;
constexpr int MLAT = NB * SEQ, MCTX = NB * CTXL, MTOT = MLAT + MCTX;
constexpr int DFF = 2816, PROJW = 6656;
constexpr int NTHR = 512;
constexpr int LDS_BYTES = 147456;

constexpr size_t WS_WB = 0;
constexpr size_t WB_BYTES = 11534336;
constexpr size_t WS_DMAT = WS_WB + WB_BYTES;
constexpr size_t WS_DC = WS_DMAT + 16777216;
constexpr size_t WS_HC = WS_DC + 262144;
constexpr size_t WS_MOD = WS_HC + 16777216;
constexpr size_t WS_ROPE = WS_MOD + 1671168;
constexpr size_t WS_LAM = WS_ROPE + 8192;
constexpr size_t WS_ABUF = WS_LAM + 256;
constexpr size_t WS_BR = WS_ABUF + 75497472;
constexpr size_t WS_BIG = WS_BR + 113246208;
constexpr size_t BIG_PROJ = 0;
constexpr size_t BIG_T = 150994944;
constexpr size_t BIG_TC = BIG_T + 67108864;
constexpr size_t BIG_VTB = BIG_TC + 8388608;
constexpr size_t BIG_VTC = BIG_VTB + 37748736;
constexpr size_t BIG_BYTES = BIG_VTC + 37748736;
constexpr size_t BIG_MERGED = 0;
constexpr size_t BIG_GSCR = 75497472;
constexpr size_t BIG_SSCR = BIG_GSCR + 33554432;
constexpr size_t BIG_GATED = 0;
constexpr size_t BIG_HB = 207618048;
constexpr size_t BIG_WUP = 233570304;
constexpr size_t BIG_WDOWN = BIG_WUP + 11534336;
static_assert(BIG_WDOWN + 5767168 <= BIG_BYTES, "big");
constexpr size_t BIG_MODPART = 0;
constexpr size_t WS_BAR = WS_BIG + BIG_BYTES;
constexpr size_t WS_END = WS_BAR + 16384;
static_assert(WS_END <= 541745280ull, "workspace");

struct Params {
    const float *x, *c, *ctx, *c_ctx, *w_ada, *b_ada, *g_mix, *g_ffn, *w_in, *b_gate, *w_a, *lam, *subln_g, *w_b, *rpb, *w_c, *w_out, *w_up, *conv_w, *conv_b, *w_down, *g_final;
    float* out; unsigned char* ws;
};

__device__ __forceinline__ unsigned cvt_pk_bf16(float lo, float hi) { unsigned r; asm volatile("v_cvt_pk_bf16_f32 %0, %1, %2" : "=v"(r) : "v"(lo), "v"(hi)); return r; }
__device__ __forceinline__ int lv(int x) { asm volatile("" : "+v"(x)); return x; }
__device__ __forceinline__ int lsg(int x) { asm volatile("" : "+s"(x)); return x; }
__device__ __forceinline__ float bperm(float v, int srclane) { return __int_as_float(__builtin_amdgcn_ds_bpermute(srclane << 2, __float_as_int(v))); }
template <class T> __device__ __forceinline__ T* lptr(T* x) { asm volatile("" : "+s"(x)); return x; }
__device__ __forceinline__ unsigned xb_ld_(unsigned* p) { return __hip_atomic_load(p, __ATOMIC_RELAXED, __HIP_MEMORY_SCOPE_AGENT); }
__device__ __forceinline__ float bf2f(unsigned short b) { return __uint_as_float(((unsigned)b) << 16); }
__device__ __forceinline__ u32x2 pack4(f32x4 v) { u32x2 w; w.x = cvt_pk_bf16(v[0], v[1]); w.y = cvt_pk_bf16(v[2], v[3]); return w; }
__device__ __forceinline__ f32x4 unpack4(u32x2 w) { f32x4 v; v[0] = __uint_as_float(w.x << 16); v[1] = __uint_as_float(w.x & 0xffff0000u); v[2] = __uint_as_float(w.y << 16); v[3] = __uint_as_float(w.y & 0xffff0000u); return v; }

constexpr int HTB = 128 * 64 * 2;
__device__ __forceinline__ int lds_byte(int r, int c) { const int st = (r >> 4) * 2 + (c >> 5), rr = r & 15, cc = c & 31, ob = rr * 64 + cc * 2; return st * 1024 + (ob ^ (((ob >> 9) & 1) << 5)); }
__device__ __forceinline__ void stage_rc(int b, int& R, int& C) { const int st = b / 1024, sb = b % 1024, swz = sb ^ (((sb >> 9) & 1) << 5); R = (st >> 1) * 16 + swz / 64; C = (st & 1) * 32 + (swz % 64) / 2; }

struct UnitD { const char* A; const char* B; int lda, ldb, nt; int pm, pn, kind, br; };

__device__ __forceinline__ bool tile_order(long L, int nM, int nN, int& pm, int& pn) {
    const int nwg = nM * nN; if (L >= nwg) return false;
    int wgid = (int)L; { const int q = nwg / 8, r = nwg % 8, xcd = wgid % 8, off = wgid / 8; wgid = (xcd < r ? xcd * (q + 1) : r * (q + 1) + (xcd - r) * q) + off; }
    const int nig = 8 * nN, gid = wgid / nig, fm = gid * 8, gsz = (nM - fm) < 8 ? (nM - fm) : 8;
    pm = fm + ((wgid % nig) % gsz); pn = (wgid % nig) / gsz; return true;
}

template <class P>
__device__ __forceinline__ void gemm_run(LAS unsigned char* lds, const P& pol, int kwid) {
    const int tid = lv(TIDX), wid = __builtin_amdgcn_readfirstlane(tid >> 6), lane = tid & 63, wr = wid >> 2, wc = wid & 3, fr = lane & 15, fq = lane >> 4;
    int R0_, C0_; { int R, C; stage_rc(tid * 16, R, C); R0_ = R; C0_ = C * 2; }
    const unsigned ldsw = (unsigned)wid * 1024u;
    const int aoff = lds_byte(wr * 64 + fr, fq * 8), boff = lds_byte(wc * 32 + fr, fq * 8);
#define G_SA(b, h) (((b) * 2 + (h)) * HTB)
#define G_SB(b, h) ((4 + (b) * 2 + (h)) * HTB)
#define G_STAGE(bufoff, gbase, ld) do { const unsigned _vo = (unsigned)(R0_ * (ld) + C0_); \
        __builtin_amdgcn_global_load_lds((const unsigned*)((const char*)(gbase) + _vo), (LAS unsigned*)(lds + (bufoff) + ldsw), 16, 0, 0); \
        __builtin_amdgcn_global_load_lds((const unsigned*)((const char*)(gbase) + 64 * (ld) + _vo), (LAS unsigned*)(lds + (bufoff) + ldsw + 8192), 16, 0, 0); } while (0)
#define G_LDA(dst, b, h) do { _Pragma("unroll") for (int m = 0; m < 4; ++m) _Pragma("unroll") for (int k = 0; k < 2; ++k) dst[m][k] = *(const LAS bf16x8*)(lds + G_SA(b, h) + aoff + m * 2048 + k * 1024); } while (0)
#define G_LDB(dst, b, h) do { _Pragma("unroll") for (int n = 0; n < 2; ++n) _Pragma("unroll") for (int k = 0; k < 2; ++k) dst[n][k] = *(const LAS bf16x8*)(lds + G_SB(b, h) + boff + n * 2048 + k * 1024); } while (0)
#define G_MMA(ai, bj, At, Bt) do { __builtin_amdgcn_s_setprio(1); _Pragma("unroll") for (int m = 0; m < 4; ++m) _Pragma("unroll") for (int n = 0; n < 2; ++n) _Pragma("unroll") for (int k = 0; k < 2; ++k) \
        acc[ai][bj][m][n] = __builtin_amdgcn_mfma_f32_16x16x32_bf16(Bt[n][k], At[m][k], acc[ai][bj][m][n], 0, 0, 0); __builtin_amdgcn_s_setprio(0); } while (0)
#define G_WAIT_V(n) asm volatile("s_waitcnt vmcnt(" #n ")" ::: "memory")
#define G_WAIT_L(n) asm volatile("s_waitcnt lgkmcnt(" #n ")" ::: "memory")
#define G_BAR __builtin_amdgcn_s_barrier()
#define G_SCHED __builtin_amdgcn_sched_barrier(0)
    UnitD cur, nxt; int ui = 0;
    if (!pol.unit(0, cur)) return;
    if constexpr (P::HANDOFF) pol.a_ready(cur, kwid);
    f32x4 acc[2][2][4][2];
#pragma unroll
    for (int a = 0; a < 2; ++a)
#pragma unroll
        for (int b = 0; b < 2; ++b)
#pragma unroll
            for (int m = 0; m < 4; ++m)
#pragma unroll
                for (int n = 0; n < 2; ++n) acc[a][b][m][n] = (f32x4){0.f, 0.f, 0.f, 0.f};
    bf16x8 At[4][2], B0[2][2], B1[2][2];
    const char* cA = cur.A; const char* cB = cur.B; int lda = cur.lda, ldb = cur.ldb;
    G_STAGE(G_SB(0, 0), cB, ldb); G_STAGE(G_SA(0, 0), cA, lda); G_STAGE(G_SB(0, 1), cB + 128 * ldb, ldb); G_STAGE(G_SA(0, 1), cA + 128 * lda, lda);
    if (wr == 1) G_BAR;
    G_WAIT_V(4); G_BAR;
    G_STAGE(G_SB(1, 0), cB + 128, ldb); G_STAGE(G_SA(1, 0), cA + 128, lda); G_STAGE(G_SB(1, 1), cB + 128 * ldb + 128, ldb);
    G_WAIT_V(6); G_BAR;
    for (;;) {
        const bool has_next = pol.unit(ui + 1, nxt);
        const char* nA = has_next ? nxt.A : cA; const char* nB = has_next ? nxt.B : cB;
        const int nlda = has_next ? nxt.lda : lda, nldb = has_next ? nxt.ldb : ldb;
        const int nt = cur.nt;
        for (int t = 0; t < nt; t += 2) {
            const bool last = (t == nt - 2);
            const char* a1 = cA + (size_t)(t + 1) * 128;
            const char* a2 = last ? nA : cA + (size_t)(t + 2) * 128; const char* b2 = last ? nB : cB + (size_t)(t + 2) * 128;
            const int la2 = last ? nlda : lda, lb2 = last ? nldb : ldb;
            const char* a3 = a2 + 128; const char* b3 = b2 + 128;
            if constexpr (P::HANDOFF) { if (last && has_next) pol.a_ready(nxt, kwid); }
            G_LDB(B0, 0, 0); G_SCHED; G_LDA(At, 0, 0); G_STAGE(G_SA(1, 1), a1 + 128 * lda, lda);
            G_WAIT_L(8); G_BAR; G_WAIT_L(0); G_MMA(0, 0, At, B0); G_BAR; G_SCHED;
            G_LDB(B1, 0, 1); G_STAGE(G_SB(0, 0), b2, lb2);
            G_BAR; G_WAIT_L(0); G_MMA(0, 1, At, B1); G_BAR;
            G_LDA(At, 0, 1); G_STAGE(G_SA(0, 0), a2, la2);
            G_BAR; G_WAIT_L(0); G_MMA(1, 0, At, B0); G_BAR; G_SCHED;
            G_STAGE(G_SB(0, 1), b2 + 128 * lb2, lb2);
            G_WAIT_V(6); G_BAR; G_MMA(1, 1, At, B1); G_BAR;
            G_LDB(B0, 1, 0); G_SCHED; G_LDA(At, 1, 0); G_STAGE(G_SA(0, 1), a2 + 128 * la2, la2);
            G_WAIT_L(8); G_BAR; G_WAIT_L(0); G_MMA(0, 0, At, B0); G_BAR; G_SCHED;
            G_LDB(B1, 1, 1); G_STAGE(G_SB(1, 0), b3, lb2);
            G_BAR; G_WAIT_L(0); G_MMA(0, 1, At, B1); G_BAR;
            G_LDA(At, 1, 1); G_STAGE(G_SA(1, 0), a3, la2);
            G_BAR; G_WAIT_L(0); G_MMA(1, 0, At, B0); G_BAR; G_SCHED;
            G_STAGE(G_SB(1, 1), b3 + 128 * lb2, lb2);
            G_WAIT_V(6); G_BAR; G_MMA(1, 1, At, B1); G_BAR;
        }
        { const int t2 = lv(TIDX); pol.epi(acc, cur, wr, wc, t2 & 15, (t2 >> 4) & 3, t2); }
        if (!has_next) break;
#pragma unroll
        for (int a = 0; a < 2; ++a)
#pragma unroll
            for (int b = 0; b < 2; ++b)
#pragma unroll
                for (int m = 0; m < 4; ++m)
#pragma unroll
                    for (int n = 0; n < 2; ++n) acc[a][b][m][n] = (f32x4){0.f, 0.f, 0.f, 0.f};
        cur = nxt; cA = nA; cB = nB; lda = nlda; ldb = nldb; ++ui;
    }
    G_WAIT_V(0);
    if (wr == 0) G_BAR;
    G_BAR;
#undef G_SA
#undef G_SB
#undef G_STAGE
#undef G_LDA
#undef G_LDB
#undef G_MMA
}

__device__ __forceinline__ f32x4 sel4(bool c, f32x4 a, f32x4 b) { f32x4 r; r[0] = c ? a[0] : b[0]; r[1] = c ? a[1] : b[1]; r[2] = c ? a[2] : b[2]; r[3] = c ? a[3] : b[3]; return r; }
__device__ __forceinline__ f32x4 ldg4(const void* base, unsigned off) { return *(const f32x4*)((const char*)base + (size_t)off); }
__device__ __forceinline__ void stg2(void* base, unsigned off, u32x2 v) { *(u32x2*)((char*)base + (size_t)off) = v; }
typedef f32x4 Acc[2][2][4][2];

struct PolInProj {
    static constexpr bool HANDOFF = false;
    const char* abuf; const char* wt; bf16_t* proj; bf16_t* T; bf16_t* Tc; bf16_t* VtB; bf16_t* VtC; const LAS unsigned char* ropel; int G, c; int nostore;
    __device__ __forceinline__ bool unit(int i, UnitD& u) const {
        int pm, pn; if (!tile_order((long)i * G + c, 144, 16, pm, pn)) return false;
        u.pm = pm; u.pn = pn; u.lda = 2048; u.ldb = 2048; u.nt = 16; u.br = 0;
        const bool sw = (pn < 4) || (pn >= 12); u.kind = sw ? 1 : 0;
        const char* act = abuf + (size_t)pm * 256 * 2048; const char* w = wt + (size_t)pn * 256 * 2048;
        u.A = sw ? w : act; u.B = sw ? act : w; return true;
    }
    __device__ __forceinline__ void epi(Acc& acc, const UnitD& u, int wr, int wc, int fr, int fq, int tid) const {
        const int pm = u.pm, pn = u.pn;
        if (nostore) { float sink = 0.f; for (int a = 0; a < 2; ++a) for (int b = 0; b < 2; ++b) for (int m = 0; m < 4; ++m) for (int n = 0; n < 2; ++n) sink += acc[a][b][m][n][0] + acc[a][b][m][n][1] + acc[a][b][m][n][2] + acc[a][b][m][n][3]; if (sink == 123.456f) proj[0] = 0; return; }
        if (u.kind) {
            const bool lat = pm < 128; const int b = lat ? (pm >> 3) : (pm - 128);
            bf16_t* base; int rowlen;
            if (pn < 4) { const int part = pn >> 1, col0 = (pn & 1) * 256;
                if (lat) { base = T + ((size_t)(b * 512 + col0) * 4096 + part * 2048 + (pm & 7) * 256); rowlen = 4096; }
                else { base = Tc + ((size_t)(b * 512 + col0) * 512 + part * 256); rowlen = 512; } }
            else { bf16_t* vt = (pn < 14) ? VtB : VtC; const int col0 = (pn & 1) * 256;
                base = vt + ((size_t)(b * 512 + col0) * 2304 + (lat ? (pm & 7) * 256 : 2048)); rowlen = 2304; }
            if (pn < 14) {
#pragma unroll
                for (int ai = 0; ai < 2; ++ai)
#pragma unroll
                    for (int m = 0; m < 4; ++m) { const int r = ai * 128 + wr * 64 + m * 16 + fr; bf16_t* rp = base + (size_t)r * rowlen + wc * 32 + 8 * fq;
#pragma unroll
                        for (int bj = 0; bj < 2; ++bj) { const u32x2 p0 = pack4(acc[ai][bj][m][0]), p1 = pack4(acc[ai][bj][m][1]); u32x4 w; w.x = p0.x; w.y = p0.y; w.z = p1.x; w.w = p1.y; *(u32x4*)(rp + bj * 128) = w; } }
            } else {
#pragma unroll
                for (int ai = 0; ai < 2; ++ai)
#pragma unroll
                    for (int m = 0; m < 4; ++m) { const int r = ai * 128 + wr * 64 + m * 16 + fr; bf16_t* rp = base + (size_t)r * rowlen + wc * 32 + 4 * fq;
#pragma unroll
                        for (int bj = 0; bj < 2; ++bj)
#pragma unroll
                            for (int n = 0; n < 2; ++n) *(u32x2*)(rp + bj * 128 + n * 16) = pack4(acc[ai][bj][m][n]); }
            }
        } else {
            const bool dorope = (pn < 8) && (pm < 128); const float sc = (pn == 4 || pn == 5 || pn == 8 || pn == 9) ? 0.125f : 1.0f;
            const int colbase = (pn - 4) * 256 + wc * 32 + 8 * fq; const int axis = wc & 1;
#pragma unroll
            for (int ai = 0; ai < 2; ++ai)
#pragma unroll
                for (int m = 0; m < 4; ++m) { const int r = ai * 128 + wr * 64 + m * 16 + fr; const int tok = pm * 256 + r; const int t = tok & 2047;
                    const int pos = axis ? (t & 63) : (t >> 6);
                    f32x4 cs = (f32x4){1.f, 1.f, 1.f, 1.f}, sn = (f32x4){0.f, 0.f, 0.f, 0.f};
                    if (dorope) { cs = *(const LAS f32x4*)(ropel + (pos * 16 + 4 * fq) * 4); sn = *(const LAS f32x4*)(ropel + 4096 + (pos * 16 + 4 * fq) * 4); }
                    bf16_t* rp = proj + (size_t)tok * 2048 + colbase;
#pragma unroll
                    for (int bj = 0; bj < 2; ++bj) { const f32x4 a = acc[ai][bj][m][0], bb = acc[ai][bj][m][1];
                        const f32x4 o0 = (a * cs - bb * sn) * sc, o1 = (a * sn + bb * cs) * sc;
                        const u32x2 p0 = pack4(o0), p1 = pack4(o1); u32x4 w; w.x = p0.x; w.y = p0.y; w.z = p1.x; w.w = p1.y; *(u32x4*)(rp + bj * 128) = w; } }
        }
    }
};

struct PolDft {
    static constexpr bool HANDOFF = false;
    const char* dmat; const char* dc; const char* T; const char* Tc; bf16_t* br; int G, c, nU;
    __device__ __forceinline__ bool unit(int i, UnitD& u) const {
        const long L = (long)i * G + c; if (L >= nU) return false;
        if (L < 256) { const int b = (int)L >> 4, pm = ((int)L >> 1) & 7, pn = (int)L & 1;
            u.A = dmat + (size_t)pm * 256 * 8192; u.lda = 8192; u.B = T + ((size_t)(b * 512 + pn * 256) * 4096) * 2; u.ldb = 8192; u.nt = 64; u.pm = b * 8 + pm; u.pn = pn; u.kind = 0; }
        else { const int b = ((int)L - 256) >> 1, pn = (int)L & 1;
            u.A = dc; u.lda = 1024; u.B = Tc + ((size_t)(b * 512 + pn * 256) * 512) * 2; u.ldb = 1024; u.nt = 8; u.pm = 128 + b; u.pn = pn; u.kind = 1; }
        u.br = 0; return true;
    }
    __device__ __forceinline__ void epi(Acc& acc, const UnitD& u, int wr, int wc, int fr, int fq, int tid) const {
        const float sc = u.kind ? 0.0055242717280199f : 0.001953125f;
#pragma unroll
        for (int ai = 0; ai < 2; ++ai)
#pragma unroll
            for (int m = 0; m < 4; ++m) { const int r = ai * 128 + wr * 64 + m * 16 + fr; bf16_t* rp = br + (size_t)(u.pm * 256 + r) * 1536 + u.pn * 256 + wc * 32 + 4 * fq;
#pragma unroll
                for (int bj = 0; bj < 2; ++bj)
#pragma unroll
                    for (int n = 0; n < 2; ++n) *(u32x2*)(rp + bj * 128 + n * 16) = pack4(acc[ai][bj][m][n] * sc); }
    }
};

struct PolMerge {
    static constexpr bool HANDOFF = false;
    const char* abuf; const char* brb; const char* wm; const float* bgate; u32x4* gscr; f32x4* sscr; bf16_t* merged; int G, c, nM;
    __device__ __forceinline__ bool unit(int i, UnitD& u) const {
        const int ti = i / 6, s = i - ti * 6; int pm, pn; if (!tile_order((long)ti * G + c, nM, 4, pm, pn)) return false;
        const int br = s >> 1; u.pm = pm; u.pn = pn; u.br = br; u.kind = s & 1; u.ldb = 3072;
        if (!(s & 1)) { u.A = abuf + (size_t)pm * 256 * 2048; u.lda = 2048; u.B = wm + ((size_t)(br * 1024 + pn * 256) * 1536) * 2; u.nt = 16; }
        else { u.A = brb + ((size_t)pm * 256 * 1536 + br * 512) * 2; u.lda = 3072; u.B = wm + ((size_t)(br * 1024 + pn * 256) * 1536 + 1024) * 2; u.nt = 8; }
        return true;
    }
    __device__ __forceinline__ void epi(Acc& acc, const UnitD& u, int wr, int wc, int fr, int fq, int tid) const {
        u32x4* gs = gscr + (size_t)blockIdx.x * 16 * 512 + tid; u32x4* ss = (u32x4*)sscr + (size_t)blockIdx.x * 16 * 512 + tid;
        if (u.kind == 0) {
            const float* bp = bgate + u.br * 1024 + u.pn * 256 + wc * 32 + 4 * fq;
#pragma unroll
            for (int bj = 0; bj < 2; ++bj) { const f32x4 b0 = *(const f32x4*)(bp + bj * 128), b1 = *(const f32x4*)(bp + bj * 128 + 16);
#pragma unroll
                for (int ai = 0; ai < 2; ++ai)
#pragma unroll
                    for (int m = 0; m < 4; ++m) { f32x4 v0 = acc[ai][bj][m][0] + b0, v1 = acc[ai][bj][m][1] + b1;
#pragma unroll
                        for (int j = 0; j < 4; ++j) { v0[j] = __builtin_amdgcn_rcpf(1.0f + __expf(-v0[j])); v1[j] = __builtin_amdgcn_rcpf(1.0f + __expf(-v1[j])); }
                        const u32x2 p0 = pack4(v0), p1 = pack4(v1); u32x4 w; w.x = p0.x; w.y = p0.y; w.z = p1.x; w.w = p1.y;
                        gs[((ai * 2 + bj) * 4 + m) * 512] = w; asm volatile("" ::: "memory"); } }
        } else {
            u32x4* sb = (u32x4*)ss;
            const f32x4 z4 = (f32x4){0.f, 0.f, 0.f, 0.f}; const bool addS = u.br > 0;
#pragma unroll
            for (int ai = 0; ai < 2; ++ai) {
                u32x4 gw[4][2], sw[4][2];
#pragma unroll
                for (int m = 0; m < 4; ++m)
#pragma unroll
                    for (int bj = 0; bj < 2; ++bj) { const int gi = ((ai * 2 + bj) * 4 + m); gw[m][bj] = gs[gi * 512]; sw[m][bj] = sb[gi * 512]; }
                asm volatile("" ::: "memory");
#pragma unroll
                for (int m = 0; m < 4; ++m) { const int r = ai * 128 + wr * 64 + m * 16 + fr; bf16_t* rp = merged + (size_t)(u.pm * 256 + r) * 1024 + u.pn * 256 + wc * 32 + 4 * fq;
#pragma unroll
                    for (int bj = 0; bj < 2; ++bj) { const int gi = ((ai * 2 + bj) * 4 + m); const u32x4 w = gw[m][bj], q = sw[m][bj];
                        u32x2 p0; p0.x = w.x; p0.y = w.y; u32x2 p1; p1.x = w.z; p1.y = w.w; u32x2 q0; q0.x = q.x; q0.y = q.y; u32x2 q1; q1.x = q.z; q1.y = q.w;
                        const f32x4 v0 = unpack4(p0) * acc[ai][bj][m][0] + sel4(addS, unpack4(q0), z4), v1 = unpack4(p1) * acc[ai][bj][m][1] + sel4(addS, unpack4(q1), z4);
                        const u32x2 o0 = pack4(v0), o1 = pack4(v1);
                        if (u.br < 2) { u32x4 o; o.x = o0.x; o.y = o0.y; o.z = o1.x; o.w = o1.y; sb[gi * 512] = o; }
                        else { *(u32x2*)(rp + bj * 128) = o0; *(u32x2*)(rp + bj * 128 + 16) = o1; } } }
                asm volatile("" ::: "memory");
            }
        }
    }
};

struct PolResid {
    static constexpr bool HANDOFF = false;
    const char* A; int lda; const char* wt; int ldb; int nt; const float* hx_in; float* hx_out; const float* hc_in; float* hc_out; const float* modl; int gidx; int G, c, nM;
    __device__ __forceinline__ bool unit(int i, UnitD& u) const {
        int pm, pn; if (!tile_order((long)i * G + c, nM, 4, pm, pn)) return false;
        u.pm = pm; u.pn = pn; u.kind = 0; u.br = 0; u.lda = lda; u.ldb = ldb; u.nt = nt;
        u.A = A + (size_t)pm * 256 * lda; u.B = wt + (size_t)pn * 256 * ldb; return true;
    }
    __device__ __forceinline__ void epi(Acc& acc, const UnitD& u, int wr, int wc, int fr, int fq, int tid) const {
        const bool lat = u.pm < 128; const int brow = lat ? (u.pm >> 3) : 16;
        const float* hin = lat ? hx_in + (size_t)u.pm * 256 * 1024 : hc_in + (size_t)(u.pm - 128) * 256 * 1024;
        float* hout = lat ? hx_out + (size_t)u.pm * 256 * 1024 : hc_out + (size_t)(u.pm - 128) * 256 * 1024;
        const int col0 = u.pn * 256 + wc * 32 + 4 * fq;
        const float* gp = modl + (size_t)brow * 6144 + gidx * 1024 + col0;
#pragma unroll
        for (int bj = 0; bj < 2; ++bj)
#pragma unroll
            for (int n = 0; n < 2; ++n) { const f32x4 g = *(const f32x4*)(gp + bj * 128 + n * 16);
#pragma unroll
                for (int ai = 0; ai < 2; ++ai)
#pragma unroll
                    for (int m = 0; m < 4; ++m) { const int r = ai * 128 + wr * 64 + m * 16 + fr; const unsigned off = (unsigned)(r * 1024 + col0 + bj * 128 + n * 16) * 4u;
                        acc[ai][bj][m][n] = ldg4(hin, off) + g * acc[ai][bj][m][n]; } }
        asm volatile("" ::: "memory");
#pragma unroll
        for (int ai = 0; ai < 2; ++ai)
#pragma unroll
            for (int m = 0; m < 4; ++m)
#pragma unroll
                for (int bj = 0; bj < 2; ++bj)
#pragma unroll
                    for (int n = 0; n < 2; ++n) { const int r = ai * 128 + wr * 64 + m * 16 + fr; const unsigned off = (unsigned)(r * 1024 + col0 + bj * 128 + n * 16) * 4u;
                        *(f32x4*)((char*)hout + (size_t)off) = acc[ai][bj][m][n]; }
    }
};


struct PolMW {
    static constexpr bool HANDOFF = true;
    const char* abuf; const char* brb; const char* wm; const float* bgate; u32x4* gscr; f32x4* sscr; bf16_t* merged;
    const char* wtout; const float* hx_in; float* hx_out; const float* hc_in; float* hc_out; const float* modl; unsigned* cnt; unsigned target; int G, c, nM; LAS unsigned char* ldsf;
    __device__ __forceinline__ void tile_of(int q, int& pm, int& pn) const { if (q < 512) tile_order(q, 128, 4, pm, pn); else { pm = 128 + ((q - 512) >> 2); pn = (q - 512) & 3; } }
    __device__ __forceinline__ bool unit(int i, UnitD& u) const {
        const bool ctxl = (nM == 144); const int nmt = (ctxl && c < 64) ? 3 : 2;
        if (i < nmt * 6) { const int ti = i / 6, s = i - ti * 6; int pm, pn; tile_of(ti < 2 ? ti * 256 + c : 512 + c, pm, pn);
            const int br = s >> 1; u.pm = pm; u.pn = pn; u.br = br; u.kind = s & 1; u.ldb = 3072;
            if (!(s & 1)) { u.A = abuf + (size_t)pm * 256 * 2048; u.lda = 2048; u.B = wm + ((size_t)(br * 1024 + pn * 256) * 1536) * 2; u.nt = 16; }
            else { u.A = brb + ((size_t)pm * 256 * 1536 + br * 512) * 2; u.lda = 3072; u.B = wm + ((size_t)(br * 1024 + pn * 256) * 1536 + 1024) * 2; u.nt = 8; }
            return true; }
        const int k = i - nmt * 6; int q;
        if (ctxl) { if (c < 64 || k >= 3) return false; q = (c - 64) + 192 * k; } else { if (k >= 2) return false; q = c + 256 * k; }
        int pm, pn; tile_of(q, pm, pn); u.pm = pm; u.pn = pn; u.br = k; u.kind = 2; u.lda = 2048; u.ldb = 2048; u.nt = 16;
        u.A = (const char*)merged + (size_t)pm * 256 * 2048; u.B = wtout + (size_t)pn * 256 * 2048; return true;
    }
    __device__ __forceinline__ int wout_q(int k) const { return (nM == 144) ? (c - 64) + 192 * k : c + 256 * k; }
    __device__ __forceinline__ void a_ready(const UnitD& u, int kwid) const {
        if (u.kind != 2) return;
        volatile LAS unsigned* flag = (volatile LAS unsigned*)(ldsf);
        if (u.br > 0 && ((flag[0] >> u.br) & 1u)) return;
        if (kwid == 0) { unsigned sp = 0; while (xb_ld_(cnt + u.pm) < target) { __builtin_amdgcn_s_sleep(2); if (++sp > (1u << 22)) break; }
            if (u.br == 0) { unsigned mask = 1u; const int nk = (nM == 144) ? 3 : 2;
                for (int k = 1; k < nk; ++k) { int pm2, pn2; tile_of(wout_q(k), pm2, pn2); if (xb_ld_(cnt + pm2) >= target) mask |= 1u << k; }
                flag[0] = mask; }
            __builtin_amdgcn_fence(__ATOMIC_ACQUIRE, "agent"); asm volatile("s_waitcnt vmcnt(0) lgkmcnt(0)" ::: "memory"); }
        asm volatile("" ::: "memory"); __builtin_amdgcn_s_barrier(); asm volatile("" ::: "memory");
    }
    __device__ __forceinline__ void epi(Acc& acc, const UnitD& u, int wr, int wc, int fr, int fq, int tid) const {
        u32x4* gs = gscr + (size_t)blockIdx.x * 16 * 512 + tid; u32x4* sb = (u32x4*)sscr + (size_t)blockIdx.x * 16 * 512 + tid;
        if (u.kind == 0) {
            const float* bp = bgate + u.br * 1024 + u.pn * 256 + wc * 32 + 4 * fq;
#pragma unroll
            for (int bj = 0; bj < 2; ++bj) { const f32x4 b0 = *(const f32x4*)(bp + bj * 128), b1 = *(const f32x4*)(bp + bj * 128 + 16);
#pragma unroll
                for (int ai = 0; ai < 2; ++ai)
#pragma unroll
                    for (int m = 0; m < 4; ++m) { f32x4 v0 = acc[ai][bj][m][0] + b0, v1 = acc[ai][bj][m][1] + b1;
#pragma unroll
                        for (int j = 0; j < 4; ++j) { v0[j] = __builtin_amdgcn_rcpf(1.0f + __expf(-v0[j])); v1[j] = __builtin_amdgcn_rcpf(1.0f + __expf(-v1[j])); }
                        const u32x2 p0 = pack4(v0), p1 = pack4(v1); u32x4 w; w.x = p0.x; w.y = p0.y; w.z = p1.x; w.w = p1.y;
                        gs[((ai * 2 + bj) * 4 + m) * 512] = w; asm volatile("" ::: "memory"); } }
        } else if (u.kind == 1) {
            const f32x4 z4 = (f32x4){0.f, 0.f, 0.f, 0.f}; const bool addS = u.br > 0;
#pragma unroll
            for (int ai = 0; ai < 2; ++ai) {
                u32x4 gw[4][2], sw[4][2];
#pragma unroll
                for (int m = 0; m < 4; ++m)
#pragma unroll
                    for (int bj = 0; bj < 2; ++bj) { const int gi = ((ai * 2 + bj) * 4 + m); gw[m][bj] = gs[gi * 512]; sw[m][bj] = sb[gi * 512]; }
                asm volatile("" ::: "memory");
#pragma unroll
                for (int m = 0; m < 4; ++m) { const int r = ai * 128 + wr * 64 + m * 16 + fr; bf16_t* rp = merged + (size_t)(u.pm * 256 + r) * 1024 + u.pn * 256 + wc * 32 + 4 * fq;
#pragma unroll
                    for (int bj = 0; bj < 2; ++bj) { const int gi = ((ai * 2 + bj) * 4 + m); const u32x4 w = gw[m][bj], q = sw[m][bj];
                        u32x2 p0; p0.x = w.x; p0.y = w.y; u32x2 p1; p1.x = w.z; p1.y = w.w; u32x2 q0; q0.x = q.x; q0.y = q.y; u32x2 q1; q1.x = q.z; q1.y = q.w;
                        const f32x4 v0 = unpack4(p0) * acc[ai][bj][m][0] + sel4(addS, unpack4(q0), z4), v1 = unpack4(p1) * acc[ai][bj][m][1] + sel4(addS, unpack4(q1), z4);
                        const u32x2 o0 = pack4(v0), o1 = pack4(v1);
                        if (u.br < 2) { u32x4 o; o.x = o0.x; o.y = o0.y; o.z = o1.x; o.w = o1.y; sb[gi * 512] = o; }
                        else {
                            __hip_atomic_store((unsigned long long*)(rp + bj * 128), ((unsigned long long)o0.y << 32) | (unsigned long long)o0.x, __ATOMIC_RELAXED, __HIP_MEMORY_SCOPE_AGENT);
                            __hip_atomic_store((unsigned long long*)(rp + bj * 128 + 16), ((unsigned long long)o1.y << 32) | (unsigned long long)o1.x, __ATOMIC_RELAXED, __HIP_MEMORY_SCOPE_AGENT); } } }
                asm volatile("" ::: "memory");
            }
            if (u.br == 2) { asm volatile("s_waitcnt vmcnt(0)" ::: "memory"); if ((tid & 63) == 0) __hip_atomic_fetch_add(cnt + u.pm, 1u, __ATOMIC_RELAXED, __HIP_MEMORY_SCOPE_AGENT); }
        } else {
            const bool lat = u.pm < 128; const int brow = lat ? (u.pm >> 3) : 16;
            const float* hin = lat ? hx_in + (size_t)u.pm * 256 * 1024 : hc_in + (size_t)(u.pm - 128) * 256 * 1024;
            float* hout = lat ? hx_out + (size_t)u.pm * 256 * 1024 : hc_out + (size_t)(u.pm - 128) * 256 * 1024;
            const int col0 = u.pn * 256 + wc * 32 + 4 * fq;
            const float* gp = modl + (size_t)brow * 6144 + 2 * 1024 + col0;
            f32x4 gv[2][2];
#pragma unroll
            for (int bj = 0; bj < 2; ++bj)
#pragma unroll
                for (int n = 0; n < 2; ++n) gv[bj][n] = *(const f32x4*)(gp + bj * 128 + n * 16);
#pragma unroll
            for (int ai = 0; ai < 2; ++ai) {
                f32x4 hv[4][2][2];
#pragma unroll
                for (int m = 0; m < 4; ++m)
#pragma unroll
                    for (int bj = 0; bj < 2; ++bj)
#pragma unroll
                        for (int n = 0; n < 2; ++n) { const int r = ai * 128 + wr * 64 + m * 16 + fr; hv[m][bj][n] = ldg4(hin, (unsigned)(r * 1024 + col0 + bj * 128 + n * 16) * 4u); }
                asm volatile("" ::: "memory");
#pragma unroll
                for (int m = 0; m < 4; ++m)
#pragma unroll
                    for (int bj = 0; bj < 2; ++bj)
#pragma unroll
                        for (int n = 0; n < 2; ++n) { const int r = ai * 128 + wr * 64 + m * 16 + fr; const unsigned off = (unsigned)(r * 1024 + col0 + bj * 128 + n * 16) * 4u;
                            *(f32x4*)((char*)hout + (size_t)off) = hv[m][bj][n] + gv[bj][n] * acc[ai][bj][m][n]; }
                asm volatile("" ::: "memory");
            }
        }
    }
};

__device__ __forceinline__ f32x4 rot4(f32x4 v, int src) { f32x4 r; r[0] = bperm(v[0], src); r[1] = bperm(v[1], src); r[2] = bperm(v[2], src); r[3] = bperm(v[3], src); return r; }
struct PolUp {
    static constexpr bool HANDOFF = false;
    const char* abuf; const char* wt; const float* cw; const float* cb; bf16_t* gated; bf16_t* hb; int G, c, nM; LAS unsigned char* ldsx;
    __device__ __forceinline__ bool unit(int i, UnitD& u) const {
        int pm, pn; if (!tile_order((long)i * G + c, nM, 22, pm, pn)) return false;
        u.pm = pm; u.pn = pn; u.kind = 0; u.br = 0; u.lda = 2048; u.ldb = 2048; u.nt = 16;
        u.A = abuf + (size_t)pm * 256 * 2048; u.B = wt + (size_t)pn * 256 * 2048; return true;
    }
    __device__ __forceinline__ void epi(Acc& acc, const UnitD& u, int wr, int wc, int fr, int fq, int tid) const {
        const int lane = tid & 63; const int srcR = (lane & 48) | ((fr + 15) & 15), srcL = (lane & 48) | ((fr + 1) & 15);
        LAS unsigned char* wl = ldsx + (wr * 4 + wc) * 1024;
        { const int arr = lane & 3, fqv = (lane >> 2) & 3, hfv = (lane >> 4) & 1, nv = (lane >> 5) & 1;
          const int cidx = hfv * DFF + u.pn * 128 + wc * 32 + nv * 16 + 4 * fqv;
          const f32x4 v = (arr < 3) ? ldg4(cw, (unsigned)(arr * 2 * DFF + cidx) * 4u) : ldg4(cb, (unsigned)cidx * 4u);
          *(LAS f32x4*)(wl + lane * 16) = v; asm volatile("s_waitcnt lgkmcnt(0)" ::: "memory"); }
#pragma unroll
        for (int n = 0; n < 2; ++n) {
            const int ja = u.pn * 128 + wc * 32 + n * 16 + 4 * fq;
#pragma unroll
            for (int ai = 0; ai < 2; ++ai) {
                const int seg = u.pm * 4 + ai * 2 + wr;
                asm volatile("" : "+v"(acc[ai][0][0][n]), "+v"(acc[ai][0][1][n]), "+v"(acc[ai][0][2][n]), "+v"(acc[ai][0][3][n]), "+v"(acc[ai][1][0][n]), "+v"(acc[ai][1][1][n]), "+v"(acc[ai][1][2][n]), "+v"(acc[ai][1][3][n]) :: "memory");
                f32x4 uv[2][4];
#pragma unroll
                for (int hf = 1; hf >= 0; --hf) {
                    const LAS f32x4* wv = (const LAS f32x4*)(wl + ((n * 2 + hf) * 4 + fq) * 64);
                    const f32x4 w0 = wv[0], w1 = wv[1], w2 = wv[2], bb = wv[3];
                    f32x4 rrp = rot4(acc[ai][hf][0][n], srcR), rlc = rot4(acc[ai][hf][0][n], srcL);
#pragma unroll
                    for (int m = 0; m < 4; ++m) {
                        const f32x4 rrc = (m == 0) ? rrp : rot4(acc[ai][hf][m][n], srcR);
                        const f32x4 rln = (m < 3) ? rot4(acc[ai][hf][m + 1][n], srcL) : rlc;
                        const f32x4 prev = sel4(fr > 0, rrc, rrp);
                        const f32x4 next = sel4(fr < 15, rlc, rln);
                        uv[hf][m] = w0 * prev + w1 * acc[ai][hf][m][n] + w2 * next + bb;
                        rrp = rrc; rlc = rln;
                    }
                    __builtin_amdgcn_sched_barrier(0);
                }
#pragma unroll
                for (int m = 0; m < 4; ++m) {
                    const int r = ai * 128 + wr * 64 + m * 16 + fr;
                    const bool bnd = (m == 0 && fr == 0) || (m == 3 && fr == 15);
                    if (!bnd) { f32x4 g;
#pragma unroll
                        for (int j = 0; j < 4; ++j) { const float a = uv[0][m][j]; g[j] = a * __builtin_amdgcn_rcpf(1.0f + __expf(-a)) * uv[1][m][j]; }
                        stg2(gated, ((unsigned)(u.pm * 256 + r) * (unsigned)DFF + (unsigned)ja) * 2u, pack4(g)); }
                    if (m == 0 && fr < 2) {
#pragma unroll
                        for (int hf = 0; hf < 2; ++hf) stg2(hb, ((unsigned)(seg * 4 + fr) * (unsigned)(2 * DFF) + (unsigned)(hf * DFF + ja)) * 2u, pack4(acc[ai][hf][m][n])); }
                    if (m == 3 && fr >= 14) {
#pragma unroll
                        for (int hf = 0; hf < 2; ++hf) stg2(hb, ((unsigned)(seg * 4 + fr - 12) * (unsigned)(2 * DFF) + (unsigned)(hf * DFF + ja)) * 2u, pack4(acc[ai][hf][m][n])); }
                }
                asm volatile("" ::: "memory"); __builtin_amdgcn_sched_barrier(0);
            }
        }
    }
};

#define SHX(v, mask) bperm((v), lane ^ (mask))
__device__ __forceinline__ float wave_sum(float v, int lane) { v += SHX(v, 32); v += SHX(v, 16); v += SHX(v, 8); v += SHX(v, 4); v += SHX(v, 2); v += SHX(v, 1); return v; }

__device__ __forceinline__ void conv_win_fold(const Params& p, unsigned char* ws, int l, float* tl, int wgi, int nwg, int kwid) {
    const float* src = p.w_in + (size_t)l * D * PROJW; bf16_t* dst = (bf16_t*)(ws + WS_WB);
    float* wsm = tl; float* tw = tl + 64 * 129;
    const int tid = lv(TIDX);
    if (wgi < 0) return;
    for (int it = wgi; it < 256; it += nwg) { const int g = it >> 6, k0 = ((it >> 2) & 15) * 64, cqb = (it & 3) * 32;
        if (tid < 128) { float s, c; sincospif((float)tid / 64.0f, &s, &c); tw[tid] = c; tw[128 + tid] = s; }
        for (int e = tid; e < 64 * 128; e += NTHR) { const int kk = e >> 7, cc = e & 127; wsm[kk * 129 + cc] = src[(size_t)(k0 + kk) * PROJW + g * 128 + cc]; }
        __syncthreads();
        const int kk = tid & 63, cq0 = tid >> 6;
        for (int i = 0; i < 4; ++i) { const int cp = cqb + cq0 + 8 * i; float ac = 0.f, as = 0.f;
            for (int cc = 0; cc < 128; ++cc) { const float w = wsm[kk * 129 + cc]; const int ix = (cc * cp) & 127; ac += w * tw[ix]; as += w * tw[128 + ix]; }
            dst[(size_t)(g * 128 + cp) * 1024 + k0 + kk] = (bf16_t)(cvt_pk_bf16(ac, 0.f) & 0xffff);
            dst[(size_t)(512 + g * 128 + cp) * 1024 + k0 + kk] = (bf16_t)(cvt_pk_bf16(as, 0.f) & 0xffff); }
        __syncthreads(); }
}
struct ConvD { const float* src; int sld, k0, scol0; bf16_t* dst; int dld, drow0, dk0; };
__device__ __forceinline__ ConvD conv_desc(const Params& p, unsigned char* ws, int l, int kind, int it) {
    ConvD d; bf16_t* wb = (bf16_t*)(ws + WS_WB);
    if (kind == 0) { const int rt = it >> 4, kt = it & 15; const int blk = rt >> 3, within = (rt & 7) * 64;
        const int sc0 = (blk == 0 ? 512 : blk == 1 ? 1024 : blk == 2 ? 2048 : blk == 3 ? 2560 : blk == 4 ? 1536 : 3072) + within;
        d.src = p.w_in + (size_t)l * D * PROJW; d.sld = PROJW; d.k0 = kt * 64; d.scol0 = sc0; d.dst = wb; d.dld = 1024; d.drow0 = 1024 + rt * 64; d.dk0 = kt * 64; }
    else if (kind == 1) {
        if (it < 1152) { const int rt = it / 24, kt = it % 24; const int br = rt >> 4, n0 = (rt & 15) * 64; d.dst = wb; d.dld = 1536; d.drow0 = br * 1024 + n0;
            if (kt < 16) { d.src = p.w_in + (size_t)l * D * PROJW; d.sld = PROJW; d.k0 = kt * 64; d.scol0 = 3584 + br * 1024 + n0; d.dk0 = kt * 64; }
            else { d.src = (br == 0 ? p.w_a : br == 1 ? p.w_b : p.w_c) + (size_t)l * 512 * 1024; d.sld = 1024; d.k0 = (kt - 16) * 64; d.scol0 = n0; d.dk0 = 1024 + (kt - 16) * 64; } }
        else { const int j = it - 1152; const int rt = j >> 4, kt = j & 15; d.src = p.w_out + (size_t)l * 1024 * 1024; d.sld = 1024; d.k0 = kt * 64; d.scol0 = rt * 64; d.dst = (bf16_t*)(ws + WS_WB + 9437184); d.dld = 1024; d.drow0 = rt * 64; d.dk0 = kt * 64; } }
    else if (kind == 2) { const int rt = it >> 4, kt = it & 15; const int drow0 = rt * 64; const int pn = drow0 >> 8, bj = (drow0 >> 7) & 1, i0 = drow0 & 127;
        d.src = p.w_up + (size_t)l * 1024 * 5632; d.sld = 5632; d.k0 = kt * 64; d.scol0 = bj * DFF + pn * 128 + i0; d.dst = (bf16_t*)(ws + WS_BIG + BIG_WUP); d.dld = 1024; d.drow0 = drow0; d.dk0 = kt * 64; }
    else { const int rt = it / 44, kt = it % 44; d.src = p.w_down + (size_t)l * DFF * 1024; d.sld = 1024; d.k0 = kt * 64; d.scol0 = rt * 64; d.dst = (bf16_t*)(ws + WS_BIG + BIG_WDOWN); d.dld = DFF; d.drow0 = rt * 64; d.dk0 = kt * 64; }
    return d;
}
__device__ __forceinline__ void conv_run(const Params& p, unsigned char* ws, int l, int kind, int ntiles, float* tl, int wgi, int nwg, int kwid) {
    const int tid = lv(TIDX);
    if (wgi < 0) return;
    for (int base = wgi * 4; base < ntiles; base += nwg * 4) {
#pragma unroll
        for (int q = 0; q < 4; ++q) { if (base + q < ntiles) { const ConvD d = conv_desc(p, ws, l, kind, base + q); float* t = tl + q * (64 * 65);
#pragma unroll
            for (int i = 0; i < 2; ++i) { const int kk = (tid >> 4) + 32 * i, c4 = (tid & 15) * 4;
                const f32x4 v = *(const f32x4*)(d.src + (size_t)(d.k0 + kk) * d.sld + d.scol0 + c4);
                t[kk * 65 + c4] = v[0]; t[kk * 65 + c4 + 1] = v[1]; t[kk * 65 + c4 + 2] = v[2]; t[kk * 65 + c4 + 3] = v[3]; } } }
        __syncthreads();
#pragma unroll
        for (int q = 0; q < 4; ++q) { if (base + q < ntiles) { const ConvD d = conv_desc(p, ws, l, kind, base + q); const float* t = tl + q * (64 * 65);
            const int r = tid >> 3, k8 = (tid & 7) * 8; float f[8];
#pragma unroll
            for (int j = 0; j < 8; ++j) f[j] = t[(k8 + j) * 65 + r];
            u32x4 w; w.x = cvt_pk_bf16(f[0], f[1]); w.y = cvt_pk_bf16(f[2], f[3]); w.z = cvt_pk_bf16(f[4], f[5]); w.w = cvt_pk_bf16(f[6], f[7]);
            *(u32x4*)(d.dst + (size_t)(d.drow0 + r) * d.dld + d.dk0 + k8) = w; } }
        __syncthreads();
    }
}
__device__ __forceinline__ void norm_phase(const float* hx, const float* hc, const float* g, const float* modl, int ish, int isc, bf16_t* abuf, int G, int nrows, int kwid) {
    const int tid_ = lv(TIDX); const int wave = tid_ >> 6, lane = tid_ & 63;
    for (int rowb = blockIdx.x * 8 + wave; rowb < nrows; rowb += G * 32) {
        f32x4 v[4][4]; int rows[4];
#pragma unroll
        for (int q = 0; q < 4; ++q) { const int r = rowb + q * G * 8; rows[q] = r; const int rc = r < nrows ? r : rowb;
            const float* src = (rc < MLAT) ? hx + (size_t)rc * 1024 : hc + (size_t)(rc - MLAT) * 1024;
#pragma unroll
            for (int i = 0; i < 4; ++i) v[q][i] = *(const f32x4*)(src + lane * 4 + 256 * i); }
#pragma unroll
        for (int q = 0; q < 4; ++q) { const int row = rows[q]; if (row < nrows) {
            const int brow = (row < MLAT) ? (row >> 11) : 16; const float* mp = modl + (size_t)brow * 6144;
            float ss = 0.f;
#pragma unroll
            for (int i = 0; i < 4; ++i) ss += v[q][i][0] * v[q][i][0] + v[q][i][1] * v[q][i][1] + v[q][i][2] * v[q][i][2] + v[q][i][3] * v[q][i][3];
            ss = wave_sum(ss, lane); const float rstd = rsqrtf(ss * (1.0f / 1024.0f) + 1e-6f);
#pragma unroll
            for (int i = 0; i < 4; ++i) { const int k = lane * 4 + 256 * i; const f32x4 gg = *(const f32x4*)(g + k), sh = *(const f32x4*)(mp + ish * 1024 + k), sc = *(const f32x4*)(mp + isc * 1024 + k);
                const f32x4 o = (v[q][i] * rstd * gg) * (sc + 1.0f) + sh; *(u32x2*)(abuf + (size_t)row * 1024 + k) = pack4(o); } } }
    }
}
__device__ __forceinline__ void final_norm(float* out, const float* g, int G, int kwid) {
    const int tid_ = lv(TIDX); const int wave = tid_ >> 6, lane = tid_ & 63;
    for (int rowb = blockIdx.x * 8 + wave; rowb < MLAT; rowb += G * 32) {
        f32x4 v[4][4];
#pragma unroll
        for (int q = 0; q < 4; ++q) { const int r = rowb + q * G * 8; const int rc = r < MLAT ? r : rowb;
#pragma unroll
            for (int i = 0; i < 4; ++i) v[q][i] = *(const f32x4*)(out + (size_t)rc * 1024 + lane * 4 + 256 * i); }
#pragma unroll
        for (int q = 0; q < 4; ++q) { const int row = rowb + q * G * 8; if (row < MLAT) { float ss = 0.f;
#pragma unroll
            for (int i = 0; i < 4; ++i) ss += v[q][i][0] * v[q][i][0] + v[q][i][1] * v[q][i][1] + v[q][i][2] * v[q][i][2] + v[q][i][3] * v[q][i][3];
            ss = wave_sum(ss, lane); const float rstd = rsqrtf(ss * (1.0f / 1024.0f) + 1e-6f);
#pragma unroll
            for (int i = 0; i < 4; ++i) { const int k = lane * 4 + 256 * i; const f32x4 gg = *(const f32x4*)(g + k); *(f32x4*)(out + (size_t)row * 1024 + k) = v[q][i] * rstd * gg; } } }
    }
}

__device__ __forceinline__ void fixup_phase(const bf16_t* hb, const float* cw, const float* cb, bf16_t* gated, int G, int nseg_all, int kwid) {
    const int total = nseg_all * 2 * (DFF / 4);
    for (int e = blockIdx.x * NTHR + lv(TIDX); e < total; e += G * NTHR) {
        const int j4 = (e % (DFF / 4)) * 4; const int sr = e / (DFF / 4); const int seg = sr >> 1, which = sr & 1;
        const bool lat = seg < 512; const int sl = lat ? (seg & 31) : ((seg - 512) & 3); const int nseg = lat ? 32 : 4;
        const bf16_t* pprev; const bf16_t* pcur; const bf16_t* pnext; bool zp = false, zn = false; int row;
        if (which == 0) { row = seg * 64; pcur = hb + (size_t)(seg * 4 + 0) * (2 * DFF); pnext = hb + (size_t)(seg * 4 + 1) * (2 * DFF); zp = (sl == 0); pprev = zp ? pcur : hb + (size_t)((seg - 1) * 4 + 3) * (2 * DFF); }
        else { row = seg * 64 + 63; pcur = hb + (size_t)(seg * 4 + 3) * (2 * DFF); pprev = hb + (size_t)(seg * 4 + 2) * (2 * DFF); zn = (sl == nseg - 1); pnext = zn ? pcur : hb + (size_t)((seg + 1) * 4 + 0) * (2 * DFF); }
        f32x4 uu[2];
#pragma unroll
        for (int hf = 0; hf < 2; ++hf) { const int cidx = hf * DFF + j4;
            f32x4 pv = unpack4(*(const u32x2*)(pprev + cidx)), cv = unpack4(*(const u32x2*)(pcur + cidx)), nv = unpack4(*(const u32x2*)(pnext + cidx));
            if (zp) pv = (f32x4){0.f, 0.f, 0.f, 0.f}; if (zn) nv = (f32x4){0.f, 0.f, 0.f, 0.f};
            uu[hf] = *(const f32x4*)(cw + cidx) * pv + *(const f32x4*)(cw + 2 * DFF + cidx) * cv + *(const f32x4*)(cw + 4 * DFF + cidx) * nv + *(const f32x4*)(cb + cidx); }
        f32x4 gg;
#pragma unroll
        for (int j = 0; j < 4; ++j) { const float a = uu[0][j]; gg[j] = a * __builtin_amdgcn_rcpf(1.0f + __expf(-a)) * uu[1][j]; }
        *(u32x2*)(gated + (size_t)row * DFF + j4) = pack4(gg);
    }
}

__device__ __forceinline__ void prep_a(const Params& p, unsigned char* ws, float* tl, int G, int kwid) {
    const int tid = lv(TIDX);
    float* modpart = (float*)(ws + WS_BIG + BIG_MODPART);
    for (int it = blockIdx.x; it < 4 * 24 * 8; it += G) { const int kc = it & 7, nc = (it >> 3) % 24, l = it / 192;
        __syncthreads();
        for (int e = tid; e < 17 * 128; e += NTHR) { const int r = e >> 7, k = e & 127; const float v = (r < 16) ? p.c[r * 1024 + kc * 128 + k] : p.c_ctx[kc * 128 + k]; tl[e] = v / (1.0f + __expf(-v)); }
        __syncthreads();
        const int col = nc * 256 + (tid & 255), kh = tid >> 8; float acc[17];
#pragma unroll
        for (int r = 0; r < 17; ++r) acc[r] = 0.f;
        const float* wp = p.w_ada + (size_t)l * 1024 * 6144 + (size_t)(kc * 128 + kh * 64) * 6144 + col;
        for (int k = 0; k < 64; ++k) { const float w = wp[(size_t)k * 6144];
#pragma unroll
            for (int r = 0; r < 17; ++r) acc[r] += tl[r * 128 + kh * 64 + k] * w; }
        float* xs = tl + 17 * 128;
        if (kh == 1) {
#pragma unroll
            for (int r = 0; r < 17; ++r) xs[r * 256 + (tid & 255)] = acc[r]; }
        __syncthreads();
        if (kh == 0) {
#pragma unroll
            for (int r = 0; r < 17; ++r) modpart[((size_t)(kc * 4 + l) * 17 + r) * 6144 + col] = acc[r] + xs[r * 256 + (tid & 255)]; }
    }
    { float* rope = (float*)(ws + WS_ROPE);
      for (int e = blockIdx.x * NTHR + tid; e < 1024; e += G * NTHR) { const int pos = e >> 4, f = e & 15; const float inv = powf(10000.0f, -(float)f / 16.0f); const float ang = (float)pos * inv; rope[e] = cosf(ang); rope[1024 + e] = sinf(ang); } }
    if (blockIdx.x == 0 && tid < 64) { float* lamv = (float*)(ws + WS_LAM);
        for (int l = 0; l < 4; ++l) { const float* lv = p.lam + l * 256; const int lane = tid & 63; const float s1 = wave_sum(lv[tid] * lv[64 + tid], lane), s2 = wave_sum(lv[128 + tid] * lv[192 + tid], lane);
            if (tid == 0) lamv[l] = expf(s1) - expf(s2) + (0.8f - 0.6f * expf(-0.3f * (float)l)); } }
    __syncthreads();
    for (int e = tid; e < 2048; e += NTHR) tl[e] = cospif((float)e / 1024.0f);
    __syncthreads();
    { bf16_t* dm = (bf16_t*)(ws + WS_DMAT);
      for (int e = blockIdx.x * NTHR + tid; e < 2048 * 512; e += G * NTHR) { const int n = e >> 9, k8 = (e & 511) * 8; float f[8];
#pragma unroll
          for (int j = 0; j < 8; ++j) { const int kp = k8 + j; const int k = (kp & ~31) | (((kp >> 2) & 1) << 4) | (((kp >> 3) & 3) << 2) | (kp & 3); f[j] = (k < 2048) ? tl[(n * k) & 2047] : -tl[(n * (k - 2048) + 1536) & 2047]; }
          u32x4 w; w.x = cvt_pk_bf16(f[0], f[1]); w.y = cvt_pk_bf16(f[2], f[3]); w.z = cvt_pk_bf16(f[4], f[5]); w.w = cvt_pk_bf16(f[6], f[7]);
          *(u32x4*)(dm + (size_t)n * 4096 + k8) = w; }
      bf16_t* dc = (bf16_t*)(ws + WS_DC);
      for (int e = blockIdx.x * NTHR + tid; e < 256 * 64; e += G * NTHR) { const int n = e >> 6, k8 = (e & 63) * 8; float f[8];
#pragma unroll
          for (int j = 0; j < 8; ++j) { const int kp = k8 + j; const int k = (kp & ~31) | (((kp >> 2) & 1) << 4) | (((kp >> 3) & 3) << 2) | (kp & 3); f[j] = (k < 256) ? tl[((n * k) & 255) * 8] : -tl[(((n * (k - 256)) & 255) * 8 + 1536) & 2047]; }
          u32x4 w; w.x = cvt_pk_bf16(f[0], f[1]); w.y = cvt_pk_bf16(f[2], f[3]); w.z = cvt_pk_bf16(f[4], f[5]); w.w = cvt_pk_bf16(f[6], f[7]);
          *(u32x4*)(dc + (size_t)n * 512 + k8) = w; } }
}
__device__ __forceinline__ void prep_b(const Params& p, unsigned char* ws, int G, int kwid) {
    const float* modpart = (const float*)(ws + WS_BIG + BIG_MODPART); float* mod = (float*)(ws + WS_MOD);
    for (int e = blockIdx.x * NTHR + lv(TIDX); e < 4 * 17 * 6144; e += G * NTHR) { const int n = e % 6144, l = e / (17 * 6144); float s = p.b_ada[l * 6144 + n];
#pragma unroll
        for (int kc = 0; kc < 8; ++kc) s += modpart[(size_t)kc * (4 * 17 * 6144) + e];
        mod[e] = s; }
}

#define MFMA16(a, b, c) __builtin_amdgcn_mfma_f32_16x16x32_bf16(a, b, c, 0, 0, 0)
constexpr float LOG2E = 1.4426950408889634f;
__device__ __forceinline__ bf16x8 mk8(u32x2 a, u32x2 b) { u32x4 w; w.x = a.x; w.y = a.y; w.z = b.x; w.w = b.y; return __builtin_bit_cast(bf16x8, w); }

__device__ __forceinline__ void diffattn_item(LAS unsigned char* lds, const bf16_t* proj, const bf16_t* vtb, bf16_t* brb, const float* subg, float lam, int post,
                              int b, int h, int qtok0, int kt0, int kt1, int kwid) {
    const int tid = lv(TIDX), wid = __builtin_amdgcn_readfirstlane(tid >> 6), lane = tid & 63, fr = lane & 15, fq = lane >> 4;
    const int sub = wid >> 2, qrow0 = qtok0 + (wid & 3) * 32;
    bf16x8 qf[2][2];
#pragma unroll
    for (int qt = 0; qt < 2; ++qt)
#pragma unroll
        for (int dh = 0; dh < 2; ++dh) qf[qt][dh] = *(const bf16x8*)(proj + (size_t)(qrow0 + qt * 16 + fr) * 2048 + h * 128 + sub * 64 + dh * 32 + fq * 8);
    f32x4 O[8][2];
#pragma unroll
    for (int et = 0; et < 8; ++et) { O[et][0] = (f32x4){0.f, 0.f, 0.f, 0.f}; O[et][1] = (f32x4){0.f, 0.f, 0.f, 0.f}; }
    float mrun[2] = {-1e30f, -1e30f}, lrun[2] = {0.f, 0.f};
    u32x4 kreg[4], vreg[4];
    const unsigned koff0 = (unsigned)((tid >> 4) * 2048 + (tid & 15) * 8) * 2u, voff0 = (unsigned)((tid >> 4) * 2304 + (tid & 15) * 8) * 2u;
#define DA_GLOAD(kt) do { const int _kr = (kt) < 16 ? b * 2048 + (kt) * 128 : MLAT + b * 256 + ((kt) - 16) * 128; \
        const char* _kb = (const char*)(proj + (size_t)_kr * 2048 + 512 + h * 128); const char* _vb = (const char*)(vtb + (size_t)(b * 512 + h * 128) * 2304 + (kt) * 128); \
        _Pragma("unroll") for (int _i = 0; _i < 4; ++_i) { \
        kreg[_i] = *(const u32x4*)(_kb + (size_t)_i * (32 * 2048 * 2) + (size_t)koff0); \
        vreg[_i] = *(const u32x4*)(_vb + (size_t)_i * (32 * 2304 * 2) + (size_t)voff0); } } while (0)
#define DA_LWRITE(kb) do { _Pragma("unroll") for (int _i = 0; _i < 4; ++_i) { const int ch = tid + 512 * _i; \
        *(LAS u32x4*)(lds + (kb) * 34816 + (ch >> 4) * 272 + (ch & 15) * 16) = kreg[_i]; \
        *(LAS u32x4*)(lds + 69632 + (kb) * 34816 + (ch >> 4) * 272 + (ch & 15) * 16) = vreg[_i]; } } while (0)
    __syncthreads();
    DA_GLOAD(kt0); DA_LWRITE(0); __syncthreads();
    for (int kt = kt0; kt < kt1; ++kt) {
        const int cur = (kt - kt0) & 1;
        if (kt + 1 < kt1) DA_GLOAD(kt + 1);
#pragma unroll
        for (int hk = 0; hk < 2; ++hk) {
        f32x4 S[4][2];
#pragma unroll
        for (int kq = 0; kq < 4; ++kq) { S[kq][0] = (f32x4){0.f, 0.f, 0.f, 0.f}; S[kq][1] = (f32x4){0.f, 0.f, 0.f, 0.f}; }
#pragma unroll
        for (int kq = 0; kq < 4; ++kq)
#pragma unroll
            for (int dh = 0; dh < 2; ++dh) { const bf16x8 kf = *(const LAS bf16x8*)(lds + cur * 34816 + (hk * 64 + kq * 16 + fr) * 272 + (sub * 64 + dh * 32 + fq * 8) * 2);
                S[kq][0] = MFMA16(kf, qf[0][dh], S[kq][0]); S[kq][1] = MFMA16(kf, qf[1][dh], S[kq][1]); }
        bf16x8 pb[2][2];
#pragma unroll
        for (int qt = 0; qt < 2; ++qt) {
            float mx = -1e30f;
#pragma unroll
            for (int kq = 0; kq < 4; ++kq)
#pragma unroll
                for (int j = 0; j < 4; ++j) mx = fmaxf(mx, S[kq][qt][j]);
            mx = fmaxf(mx, SHX(mx, 16)); mx = fmaxf(mx, SHX(mx, 32));
            const float mxs = mx * LOG2E; const float mnew = (mxs > mrun[qt] + 8.0f) ? mxs : mrun[qt]; const float alpha = __builtin_amdgcn_exp2f(mrun[qt] - mnew); mrun[qt] = mnew;
            f32x4 lsv = (f32x4){0.f, 0.f, 0.f, 0.f}; u32x2 pk[4];
#pragma unroll
            for (int kq = 0; kq < 4; ++kq) { const f32x4 t = S[kq][qt] * LOG2E - mnew; f32x4 pv;
#pragma unroll
                for (int j = 0; j < 4; ++j) pv[j] = __builtin_amdgcn_exp2f(t[j]);
                lsv += pv; pk[kq] = pack4(pv); }
            lrun[qt] = lrun[qt] * alpha + ((lsv[0] + lsv[1]) + (lsv[2] + lsv[3]));
            if (__builtin_amdgcn_ballot_w64(alpha != 1.0f) != 0ull) {
#pragma unroll
                for (int et = 0; et < 8; ++et) O[et][qt] *= alpha; }
            pb[qt][0] = mk8(pk[0], pk[1]); pb[qt][1] = mk8(pk[2], pk[3]);
        }
#pragma unroll
        for (int kc2 = 0; kc2 < 2; ++kc2)
#pragma unroll
            for (int et = 0; et < 8; ++et) { const bf16x8 vf = *(const LAS bf16x8*)(lds + 69632 + cur * 34816 + (et * 16 + fr) * 272 + (hk * 64 + kc2 * 32 + fq * 8) * 2);
                O[et][0] = MFMA16(vf, pb[0][kc2], O[et][0]); O[et][1] = MFMA16(vf, pb[1][kc2], O[et][1]); }
        }
        if (kt + 1 < kt1) DA_LWRITE(cur ^ 1);
        __syncthreads();
    }
#undef DA_GLOAD
#undef DA_LWRITE
#pragma unroll
    for (int qt = 0; qt < 2; ++qt) { float l = lrun[qt]; l += SHX(l, 16); l += SHX(l, 32); const float inv = 1.0f / l;
#pragma unroll
        for (int et = 0; et < 8; ++et) O[et][qt] *= inv; }
    if (sub == 1) {
#pragma unroll
        for (int qt = 0; qt < 2; ++qt)
#pragma unroll
            for (int et = 0; et < 8; ++et) *(LAS f32x4*)(lds + ((wid & 3) * 16 + qt * 8 + et) * 1024 + lane * 16) = O[et][qt]; }
    __syncthreads();
    if (sub == 0) {
#pragma unroll
        for (int qt = 0; qt < 2; ++qt) { float ss = 0.f;
#pragma unroll
            for (int et = 0; et < 8; ++et) { const f32x4 x1 = *(const LAS f32x4*)(lds + ((wid & 3) * 16 + qt * 8 + et) * 1024 + lane * 16); const f32x4 o = O[et][qt] - x1 * lam; O[et][qt] = o;
                ss += o[0] * o[0] + o[1] * o[1] + o[2] * o[2] + o[3] * o[3]; }
            ss += SHX(ss, 16); ss += SHX(ss, 32);
            const int li_ = post; const int pbits_ = lsg(li_ == 0 ? (int)0x3f4ccccdu : li_ == 1 ? (int)0x3f24fd5cu : li_ == 2 ? (int)0x3f077f5au : (int)0x3ee34c57u); const float postf = __int_as_float(pbits_);
            const float rstd = rsqrtf(ss * (1.0f / 128.0f) + 1e-5f) * postf;
            bf16_t* rp = brb + (size_t)(qrow0 + qt * 16 + fr) * 1536 + 512 + h * 128 + fq * 4;
#pragma unroll
            for (int et = 0; et < 8; ++et) { const f32x4 g = *(const f32x4*)(subg + et * 16 + fq * 4); *(u32x2*)(rp + et * 16) = pack4(O[et][qt] * rstd * g); } } }
    __syncthreads();
}

__device__ __forceinline__ void na_chunk(const LAS unsigned char* kb, const LAS unsigned char* vb, int vstride, int kbase, const bf16x8 (&qf)[2], f32x4 (&O)[4], float& mrun, float& lrun,
                                         int fr, int fq, bool usebias, const LAS float* rpbs, int rowidx0, const int (&dcoff)[8]) {
    const int lane = fq * 16 + fr;
    f32x4 S[4];
#pragma unroll
    for (int kq = 0; kq < 4; ++kq) { S[kq] = (f32x4){0.f, 0.f, 0.f, 0.f};
#pragma unroll
        for (int dh = 0; dh < 2; ++dh) { const bf16x8 kf = *(const LAS bf16x8*)(kb + (kbase + kq * 16 + fr) * 144 + (dh * 32 + fq * 8) * 2); S[kq] = MFMA16(kf, qf[dh], S[kq]); } }
    if (usebias) {
#pragma unroll
        for (int kq = 0; kq < 4; ++kq)
#pragma unroll
            for (int j = 0; j < 4; ++j) { const int dco = dcoff[(kq & 1) * 4 + j];
                const float bv = *(const LAS float*)((const LAS unsigned char*)rpbs + (rowidx0 + (kq >> 1)) * 124 + (dco < 0 ? 0 : dco)); S[kq][j] = dco >= 0 ? S[kq][j] + bv : -1e30f; } }
    float mx = -1e30f;
#pragma unroll
    for (int kq = 0; kq < 4; ++kq)
#pragma unroll
        for (int j = 0; j < 4; ++j) mx = fmaxf(mx, S[kq][j]);
    mx = fmaxf(mx, SHX(mx, 16)); mx = fmaxf(mx, SHX(mx, 32));
    const float mnew = fmaxf(mrun, mx * LOG2E); const float alpha = __builtin_amdgcn_exp2f(mrun - mnew); mrun = mnew;
    f32x4 lsv = (f32x4){0.f, 0.f, 0.f, 0.f}; u32x2 pk[4];
#pragma unroll
    for (int kq = 0; kq < 4; ++kq) { const f32x4 t = S[kq] * LOG2E - mnew; f32x4 pv;
#pragma unroll
        for (int j = 0; j < 4; ++j) pv[j] = __builtin_amdgcn_exp2f(t[j]);
        lsv += pv; pk[kq] = pack4(pv); }
    lrun = lrun * alpha + ((lsv[0] + lsv[1]) + (lsv[2] + lsv[3]));
    const bf16x8 pb0 = mk8(pk[0], pk[1]), pb1 = mk8(pk[2], pk[3]);
#pragma unroll
    for (int et = 0; et < 4; ++et) { O[et] *= alpha;
        const LAS unsigned char* vp = vb + (et * 16 + fr) * vstride + (kbase + fq * 4) * 2;
        O[et] = MFMA16(mk8(*(const LAS u32x2*)vp, *(const LAS u32x2*)(vp + 32)), pb0, O[et]);
        O[et] = MFMA16(mk8(*(const LAS u32x2*)(vp + 64), *(const LAS u32x2*)(vp + 96)), pb1, O[et]); }
}

__device__ __forceinline__ void na_item(LAS unsigned char* lds, const bf16_t* proj, const bf16_t* vtc, const float* rpbh, bf16_t* brb, int b, int h, int mode, int jblk, int band, int kwid) {
    const int tid = lv(TIDX), wid = __builtin_amdgcn_readfirstlane(tid >> 6), lane = tid & 63, fr = lane & 15, fq = lane >> 4;
    const int qtok = (mode == 0) ? b * 2048 + (band * 8 + wid) * 64 + jblk * 16 + fr : MLAT + b * 256 + band * 128 + wid * 16 + fr;
    bf16x8 qf[2];
#pragma unroll
    for (int dh = 0; dh < 2; ++dh) qf[dh] = *(const bf16x8*)(proj + (size_t)qtok * 2048 + 1024 + h * 64 + dh * 32 + fq * 8);
    f32x4 O[4];
#pragma unroll
    for (int et = 0; et < 4; ++et) O[et] = (f32x4){0.f, 0.f, 0.f, 0.f};
    float mrun = -1e30f, lrun = 0.f;
    LAS float* rpbs = (LAS float*)(lds + 133120);
    __syncthreads();
#pragma unroll
    for (int i = 0; i < 4; ++i) { const int ch = tid + 512 * i; const int key = ch >> 3, c16 = ch & 7;
        *(LAS u32x4*)(lds + key * 144 + c16 * 16) = *(const u32x4*)(proj + (size_t)(MLAT + b * 256 + key) * 2048 + 1536 + h * 64 + c16 * 8);
        const int e = ch >> 5, d16 = ch & 31;
        *(LAS u32x4*)(lds + 36864 + e * 528 + d16 * 16) = *(const u32x4*)(vtc + (size_t)(b * 512 + h * 64 + e) * 2304 + 2048 + d16 * 8); }
    if (mode == 0) for (int e = tid; e < 465; e += NTHR) rpbs[e] = rpbh[e];
    const int rfirst = band * 8; const int R0 = min(max(rfirst - 4, 0), 24), nrows = min(max(rfirst + 7 - 4, 0), 24) + 8 - R0; const int kc0 = min(max(16 * jblk - 8, 0), 32);
    const int per_e = nrows * 4;
    int dcoff[8];
    { const int qcol_ = jblk * 16 + fr; const int c0_ = min(max(qcol_ - 8, 0), 48);
#pragma unroll
      for (int t = 0; t < 8; ++t) { const int kcol = kc0 + (t >> 2) * 16 + fq * 4 + (t & 3); const bool ok = (kcol >= c0_) && (kcol < c0_ + 16); const int dc = min(max(kcol - qcol_ + 15, 0), 30); dcoff[t] = ok ? dc * 4 : -1; } }
    u32x4 kl[8], vl[8];
    if (mode == 0) {
#pragma unroll
        for (int i = 0; i < 8; ++i) { const int ch = tid + 512 * i;
            if (ch < nrows * 256) { const int key = ch >> 3, c16 = ch & 7; const int il = key >> 5, w = key & 31;
                kl[i] = *(const u32x4*)(proj + (size_t)(b * 2048 + (R0 + il) * 64 + kc0 + w) * 2048 + 1536 + h * 64 + c16 * 8); }
            if (ch < 64 * per_e) { const int e = ch / per_e, rem = ch - e * per_e; const int il = rem >> 2, c16 = rem & 3;
                vl[i] = *(const u32x4*)(vtc + (size_t)(b * 512 + h * 64 + e) * 2304 + (R0 + il) * 64 + kc0 + c16 * 8); } }
    }
    __syncthreads();
#pragma unroll 1
    for (int c = 0; c < 4; ++c) na_chunk(lds, lds + 36864, 528, c * 64, qf, O, mrun, lrun, fr, fq, false, rpbs, 0, dcoff);
    if (mode == 0) {
        __syncthreads();
#pragma unroll
        for (int i = 0; i < 8; ++i) { const int ch = tid + 512 * i;
            if (ch < nrows * 256) { const int key = ch >> 3, c16 = ch & 7; *(LAS u32x4*)(lds + key * 144 + c16 * 16) = kl[i]; }
            if (ch < 64 * per_e) { const int e = ch / per_e, rem = ch - e * per_e; const int il = rem >> 2, c16 = rem & 3; *(LAS u32x4*)(lds + 69120 + e * 976 + (il * 32 + c16 * 8) * 2) = vl[i]; } }
        __syncthreads();
        const int r = band * 8 + wid; const int r0 = min(max(r - 4, 0), 24); const int ilb = r0 - R0; const int qcol = jblk * 16 + fr;
#pragma unroll 1
        for (int c = 0; c < 4; ++c) na_chunk(lds, lds + 69120, 976, (ilb + 2 * c) * 32, qf, O, mrun, lrun, fr, fq, true, rpbs, r0 + 2 * c - r + 7, dcoff);
    }
    float l = lrun; l += SHX(l, 16); l += SHX(l, 32); const float inv = 1.0f / l;
    bf16_t* rp = brb + (size_t)qtok * 1536 + 1024 + h * 64 + fq * 4;
#pragma unroll
    for (int et = 0; et < 4; ++et) *(u32x2*)(rp + et * 16) = pack4(O[et] * inv);
    __syncthreads();
}


#define XB_TMO      128
#define XB_XCNT(j)  (256  + 64 * (j))
#define XB_XSUB(j)  (1280 + 64 * (j))
#define XB_XGEN(j)  (2304 + 64 * (j))
#define XB_TOP      3328
#define XB_TOPGEN   3392
#define XCD_BAR_WORDS 3456
#define XB_SPIN_CAP (1u << 22)
__device__ __forceinline__ unsigned xb_ld(unsigned* p)              { return __hip_atomic_load(p, __ATOMIC_RELAXED, __HIP_MEMORY_SCOPE_AGENT); }
__device__ __forceinline__ unsigned xb_add(unsigned* p, unsigned v) { return __hip_atomic_fetch_add(p, v, __ATOMIC_RELAXED, __HIP_MEMORY_SCOPE_AGENT); }
__device__ __forceinline__ unsigned xb_xcc_id() { return (unsigned)__builtin_amdgcn_s_getreg((3 << 11) | 20) & 0xFu; }
#define XB_SPIN(cond, bar) do { unsigned _sp = 0; while (cond) { __builtin_amdgcn_s_sleep(1); \
    if ((++_sp & 255u) == 0u) { if (xb_ld(&(bar)[XB_TMO])) break; if (_sp > XB_SPIN_CAP) { atomicAdd(&(bar)[XB_TMO], 1u); break; } } } } while (0)
__device__ __forceinline__ void xcd_barrier_complete(unsigned* bar, unsigned x, unsigned G, unsigned& nloc, unsigned& nx) {
    unsigned sum, cnt, mine, sp = 0u;
    for (;;) {
        sum = 0u; cnt = 0u; mine = 0u;
#pragma unroll
        for (unsigned j = 0; j < 16; ++j) { const unsigned c = xb_ld(&bar[XB_XCNT(j)]); sum += c; cnt += (c > 0u) ? 1u : 0u; mine = (j == x) ? c : mine; }
        if (sum == G) break;
        __builtin_amdgcn_s_sleep(1);
        if ((++sp & 255u) == 0u) { if (xb_ld(&bar[XB_TMO])) break; if (sp > XB_SPIN_CAP) { atomicAdd(&bar[XB_TMO], 1u); break; } }
    }
    nloc = mine > 0u ? mine : 1u; nx = cnt > 0u ? cnt : 1u;
}
__device__ __forceinline__ void xcd_barrier(unsigned* bar, volatile LAS unsigned* st, unsigned G, int kwid) {
    asm volatile("s_waitcnt vmcnt(0)" ::: "memory");
    __syncthreads();
    if (TIDX == 0) {
        __builtin_amdgcn_s_waitcnt(0);
        const unsigned x = xb_xcc_id();
        unsigned nloc = st[0], nx = st[1];
        if (nloc == 0u) { xcd_barrier_complete(bar, x, G, nloc, nx); st[0] = nloc; st[1] = nx; }
        const unsigned old = xb_add(&bar[XB_XSUB(x)], 1u);
        const unsigned gen = old / nloc;
        if (old + 1u == (gen + 1u) * nloc) {
            __builtin_amdgcn_fence(__ATOMIC_RELEASE, "agent");
            asm volatile("s_waitcnt vmcnt(0)" ::: "memory");
            const unsigned og = xb_add(&bar[XB_TOP], 1u);
            const unsigned tg = og / nx;
            if (og + 1u == (tg + 1u) * nx) xb_add(&bar[XB_TOPGEN], 1u);
            else XB_SPIN(xb_ld(&bar[XB_TOPGEN]) == tg, bar);
            __builtin_amdgcn_fence(__ATOMIC_ACQUIRE, "agent");
            xb_add(&bar[XB_XGEN(x)], 1u);
            asm volatile("s_waitcnt vmcnt(0)" ::: "memory");
        } else {
            XB_SPIN(xb_ld(&bar[XB_XGEN(x)]) == gen, bar);
            __builtin_amdgcn_fence(__ATOMIC_ACQUIRE, "agent");
            asm volatile("s_waitcnt vmcnt(0)" ::: "memory");
        }
    }
    __syncthreads();
}

#ifdef REPEAT_S
constexpr int NPHASE = 2 + 10 * DEPTH + 1;
#else
constexpr int NPHASE = 2 + 8 * DEPTH + 1;
#endif
#ifndef EN
#define EN 0xFFFF
#endif
#define ON(k) ((EN >> (k)) & 1)
__global__ void __launch_bounds__(NTHR) mega(Params p_in, int ph_lo, int ph_hi) {
    extern __shared__ __attribute__((aligned(16))) unsigned char smem[];
    LAS unsigned char* lds = (LAS unsigned char*)smem;
    float* tl = (float*)smem;
    const int kwid = __builtin_amdgcn_readfirstlane((int)threadIdx.x >> 6);
    cg::grid_group grid = cg::this_grid();
    volatile LAS unsigned* xst = (volatile LAS unsigned*)(lds + LDS_BYTES - 16);
    { unsigned* bar0 = (unsigned*)(p_in.ws + WS_BAR); if (TIDX == 0) { xst[0] = 0u; xst[1] = 0u; (void)xb_add(&bar0[XB_XCNT(xb_xcc_id())], 1u); } __syncthreads(); }
    for (int ph = ph_lo; ph < ph_hi; ++ph) {
        const int G = lsg((int)gridDim.x), c = lsg((int)blockIdx.x);
        const Params& p = p_in; unsigned char* ws = lptr(p_in.ws); float* outp = lptr(p_in.out);
        const float* mod = (const float*)(ws + WS_MOD);
        bf16_t* abuf = (bf16_t*)(ws + WS_ABUF); bf16_t* brb = (bf16_t*)(ws + WS_BR);
        float* hc = (float*)(ws + WS_HC);
        unsigned char* big = ws + WS_BIG;
        if (ph == 0) { if (ON(0)) prep_a(p, ws, tl, G, kwid); }
        else if (ph == 1) { if (ON(0)) prep_b(p, ws, G, kwid); }
        else if (ph == NPHASE - 1) final_norm(outp, p.g_final, G, kwid);
        else {
#ifdef REPEAT_S
            const int l = (ph - 2) / 10, s_ = (ph - 2) % 10; const int s = (s_ <= REPEAT_S) ? s_ : s_ - 1;
#define PROBE_NOSTORE ((s_ == REPEAT_S + 1) ? 1 : 0)
#else
            const int l = (ph - 2) / 8, s_raw = (ph - 2) % 8; const int s = s_raw < 4 ? s_raw : s_raw + 1;
#define PROBE_NOSTORE 0
#endif
            const float* modl = mod + (size_t)l * 17 * 6144;
            const bool lastl = (l == DEPTH - 1); const int nMl = lastl ? 128 : 144;
            const float* hx_in = (l == 0) ? p.x : outp; const float* hc_in = (l == 0) ? p.ctx : hc;
            const int swg = lastl ? c : c - 64, snw = lastl ? G : G - 64;
            if (s == 0) { if (l == 0) { conv_run(p, ws, l, 0, 768, tl, c, G, kwid); conv_win_fold(p, ws, l, tl, c, G, kwid); } norm_phase(hx_in, hc_in, p.g_mix + l * 1024, modl, 0, 1, abuf, G, MTOT, kwid); }
            else if (s == 1) { PolInProj pol{(const char*)abuf, (const char*)(ws + WS_WB), (bf16_t*)(big + BIG_PROJ), (bf16_t*)(big + BIG_T), (bf16_t*)(big + BIG_TC), (bf16_t*)(big + BIG_VTB), (bf16_t*)(big + BIG_VTC), lds + 131072, G, c, PROBE_NOSTORE};
                { const int t_ = lv(TIDX); const float* rope = (const float*)(ws + WS_ROPE); for (int e = t_; e < 2048; e += NTHR) *(LAS float*)(lds + 131072 + e * 4) = rope[e]; __syncthreads(); }
                gemm_run(lds, pol, kwid); }
            else if (s == 2) {
                conv_run(p, ws, l, 1, 1408, tl, c, G, kwid);
                { PolDft pol{(const char*)(ws + WS_DMAT), (const char*)(ws + WS_DC), (const char*)(big + BIG_T), (const char*)(big + BIG_TC), brb, G, c, lastl ? 256 : 288}; gemm_run(lds, pol, kwid); }
                const bf16_t* proj = (const bf16_t*)(big + BIG_PROJ);
                const float lam = __int_as_float(__builtin_amdgcn_readfirstlane(__float_as_int(((const float*)(ws + WS_LAM))[l]))); const int post = l;
                for (long L = c; L < (lastl ? 1024 : 1024 + 128); L += G) {
                    int b_, h_, q0_, k0_;
                    if (L < 1024) { const int rr = (int)L >> 8, cc = (int)L & 255; const int pair = rr * 16 + (cc & 7) * 2 + (cc >> 7), qb = (cc >> 3) & 15; b_ = pair >> 2; h_ = pair & 3; q0_ = b_ * 2048 + qb * 128; k0_ = 0; }
                    else { const int j = (int)L - 1024; b_ = j >> 3; h_ = (j >> 1) & 3; q0_ = MLAT + b_ * 256 + (j & 1) * 128; k0_ = 16; }
                    diffattn_item(lds, proj, (const bf16_t*)(big + BIG_VTB), brb, p.subln_g + l * 128, lam, post, b_, h_, q0_, k0_, 18, kwid); }
                for (long L = c; L < (lastl ? 2048 : 2048 + 256); L += G) {
                    int b_, h_, mode_, j_, band_;
                    if (L < 2048) { const int rr = (int)L >> 8, cc = (int)L & 255; const int pair = rr * 16 + (cc & 7) * 2 + (cc >> 7), sub = (cc >> 3) & 15; b_ = pair >> 3; h_ = pair & 7; mode_ = 0; j_ = sub & 3; band_ = sub >> 2; }
                    else { const int j = (int)L - 2048; b_ = j >> 4; h_ = (j >> 1) & 7; mode_ = 1; j_ = 0; band_ = j & 1; }
                    na_item(lds, proj, (const bf16_t*)(big + BIG_VTC), p.rpb + (size_t)(l * 8 + h_) * 465, brb, b_, h_, mode_, j_, band_, kwid); }
            }
            else if (s == 3) { PolMW pol{(const char*)abuf, (const char*)brb, (const char*)(ws + WS_WB), p.b_gate + l * 3072, (u32x4*)(big + BIG_GSCR), (f32x4*)(big + BIG_SSCR), (bf16_t*)(big + BIG_MERGED),
                    (const char*)(ws + WS_WB + 9437184), hx_in, outp, hc_in, hc, modl, (unsigned*)(ws + WS_BAR + 14336), 32u * (unsigned)(l + 1), G, c, nMl, lds + LDS_BYTES - 8};
                gemm_run(lds, pol, kwid);
                conv_run(p, ws, l, 2, 1408, tl, swg, snw, kwid); conv_run(p, ws, l, 3, 704, tl, swg, snw, kwid); }
            else if (s == 5) { norm_phase(outp, hc, p.g_ffn + l * 1024, modl, 3, 4, abuf, G, lastl ? MLAT : MTOT, kwid); }
            else if (s == 6) { PolUp pol{(const char*)abuf, (const char*)(big + BIG_WUP), p.conv_w + (size_t)l * 3 * 5632, p.conv_b + (size_t)l * 5632, (bf16_t*)(big + BIG_GATED), (bf16_t*)(big + BIG_HB), G, c, nMl, lds + 131072}; gemm_run(lds, pol, kwid); }
            else if (s == 7) { fixup_phase((const bf16_t*)(big + BIG_HB), p.conv_w + (size_t)l * 3 * 5632, p.conv_b + (size_t)l * 5632, (bf16_t*)(big + BIG_GATED), G, lastl ? 512 : 576, kwid); }
            else { PolResid pol{(const char*)(big + BIG_GATED), 5632, (const char*)(big + BIG_WDOWN), 5632, 44, outp, outp, hc, hc, modl, 5, G, c, nMl}; gemm_run(lds, pol, kwid);
                if (!lastl) { conv_run(p, ws, l + 1, 0, 768, tl, swg, snw, kwid); conv_win_fold(p, ws, l + 1, tl, swg, snw, kwid); } }
        }
        if (ph + 1 < ph_hi) {
            if (ph_lo < 0) { __threadfence(); grid.sync(); }
            xcd_barrier((unsigned*)(ws + WS_BAR), xst, (unsigned)G, kwid);
        }
    }
}

extern "C" void kernel_launch(void* const* d_in, const int* in_sizes, int n_in, void* d_out, int out_size, void* d_ws, size_t ws_size, hipStream_t stream) {
    static int grid_blocks = 0;
    if (grid_blocks == 0) {
        if (n_in != 22 || ws_size < WS_END) { fprintf(stderr, "kernel_launch: unexpected n_in %d or ws_size %zu (need %zu)\n", n_in, ws_size, (size_t)WS_END); grid_blocks = -1; return; }
        if (hipFuncSetAttribute((const void*)mega, hipFuncAttributeMaxDynamicSharedMemorySize, LDS_BYTES) != hipSuccess) { fprintf(stderr, "hipFuncSetAttribute failed\n"); grid_blocks = -1; return; }
        int dev = 0, cus = 0, per_cu = 0;
        hipGetDevice(&dev); hipDeviceGetAttribute(&cus, hipDeviceAttributeMultiprocessorCount, dev);
        hipOccupancyMaxActiveBlocksPerMultiprocessor(&per_cu, (const void*)mega, NTHR, LDS_BYTES);
        if (per_cu < 1) { fprintf(stderr, "occupancy query says %d blocks/CU\n", per_cu); per_cu = 1; }
        (void)hipGetLastError();
        grid_blocks = cus;
    }
    if (grid_blocks < 0) return;
    if (hipMemsetAsync((char*)d_ws + WS_BAR, 0, 16384, stream) != hipSuccess) { fprintf(stderr, "memset failed\n"); return; }
    Params p{};
    const float** pp = (const float**)&p;
    for (int i = 0; i < 22; ++i) pp[i] = (const float*)d_in[i];
    p.out = (float*)d_out; p.ws = (unsigned char*)d_ws;
    int lo = 0, hi = NPHASE;
    void* args[] = {&p, &lo, &hi};
    hipError_t e = hipLaunchCooperativeKernel((const void*)mega, dim3(grid_blocks), dim3(NTHR), args, LDS_BYTES, stream);
    if (e != hipSuccess) fprintf(stderr, "cooperative launch failed: %s (grid %d)\n", hipGetErrorString(e), grid_blocks);
}
```
